# Optimizing an MI355X kernel written in HIP

```python
import math
import jax, jax.numpy as jnp
from jax import lax
import numpy as np

D_MODEL = 1024
BATCH = 8
SEQ = 4096
DEPTH = 2

CTX_LEN = 256
GRID_W = 64
ROPE_THETA = 10000.0
EPS = 1e-6
Q_BLOCK = 128
N_MOD = 9

D_FF = 2816

CHUNK = 128
A_GROUPS = 8
A_WIDTH = 1024
A_GROUP_W = A_WIDTH // A_GROUPS

B_HEADS = 8
B_HEAD_DIM = 64
B_WIDTH = B_HEADS * 2 * B_HEAD_DIM

C_HEADS = 16
C_NOPE = 64
C_ROPE = 32
C_VDIM = 64
C_Q_RANK = 512
C_KV_RANK = 256
C_WIDTH = C_HEADS * C_VDIM

N_BRANCH = 3
BRANCH_W = 1024
IN_SIZES = (2 * A_WIDTH, B_WIDTH, B_WIDTH, B_WIDTH, C_Q_RANK, C_KV_RANK, C_ROPE, N_BRANCH * D_MODEL)
D_IN = 2 * A_WIDTH + 3 * B_WIDTH + C_Q_RANK + C_KV_RANK + C_ROPE + N_BRANCH * D_MODEL

kernel_name = "hybrid_gated_gmlp_diffattn_mla_macaron_dit"


def rms_norm(x, g):
    xf = x.astype(jnp.float32)
    y = xf * lax.rsqrt(jnp.mean(xf * xf, axis=-1, keepdims=True) + EPS)
    return (y * g.astype(jnp.float32)).astype(x.dtype)


def layer_norm(x, g, b):
    xf = x.astype(jnp.float32)
    mu = jnp.mean(xf, axis=-1, keepdims=True)
    xc = xf - mu
    y = xc * lax.rsqrt(jnp.mean(xc * xc, axis=-1, keepdims=True) + EPS)
    return (y * g.astype(jnp.float32) + b.astype(jnp.float32)).astype(x.dtype)


def modulate(h, shift, scale):
    return h * (1.0 + scale) + shift


def swiglu(h, w13, w2):
    a, b = jnp.split(h @ w13, 2, axis=-1)
    return (jax.nn.silu(a) * b) @ w2


def apply_rope(x, cos, sin):
    x1, x2 = jnp.split(x, 2, axis=-1)
    return jnp.concatenate([x1 * cos - x2 * sin, x2 * cos + x1 * sin], axis=-1)


def axial_rope_tables(rows, rot_dim, dtype):
    row = jnp.repeat(jnp.arange(rows), GRID_W)
    col = jnp.tile(jnp.arange(GRID_W), rows)
    n_freq = rot_dim // 4
    freqs = ROPE_THETA ** (-jnp.arange(n_freq, dtype=jnp.float32) / n_freq)
    ang = jnp.concatenate([row[:, None] * freqs, col[:, None] * freqs], axis=-1)
    return jnp.cos(ang).astype(dtype), jnp.sin(ang).astype(dtype)


def sweep_query_blocks(fn, q):
    bsz, n = q.shape[0], q.shape[1]
    nb = n // Q_BLOCK
    qb = jnp.moveaxis(q.reshape((bsz, nb, Q_BLOCK) + q.shape[2:]), 1, 0)
    ob = lax.map(fn, qb)
    return jnp.moveaxis(ob, 0, 1).reshape((bsz, n) + ob.shape[3:])


def chunk_spatial_gating(a, ln_g, ln_b, w_s, b_s):
    u, v = jnp.split(jax.nn.gelu(a), 2, axis=-1)
    v = layer_norm(v, ln_g, ln_b)
    bsz, n = v.shape[0], v.shape[1]
    v = v.reshape(bsz, n // CHUNK, CHUNK, A_GROUPS, A_GROUP_W)
    z = jnp.einsum('gij,bnjgc->bnigc', w_s, v) + b_s.T[:, :, None]
    return u * z.reshape(bsz, n, A_WIDTH)


def diff_softmax_attend(q, k, v, lam):
    s = jnp.einsum('bqhmd,bkhmd->bhmqk', q, k).astype(jnp.float32) * (B_HEAD_DIM ** -0.5)
    p = jax.nn.softmax(s, axis=-1)
    w = p[:, :, 0] - lam * p[:, :, 1]
    return jnp.einsum('bhqk,bkhe->bqhe', w.astype(v.dtype), v)


def diff_post(o, subln_g, lam_init):
    bsz, n = o.shape[0], o.shape[1]
    return (rms_norm(o, subln_g) * (1.0 - lam_init)).reshape(bsz, n, B_WIDTH)


def mla_attend(q, kn, kr, v):
    qn, qr = q[..., :C_NOPE], q[..., C_NOPE:]
    s = (jnp.einsum('bqhd,bkhd->bhqk', qn, kn) + jnp.einsum('bqhr,bkr->bhqk', qr, kr)).astype(jnp.float32)
    p = jax.nn.softmax(s * ((C_NOPE + C_ROPE) ** -0.5), axis=-1)
    return jnp.einsum('bhqk,bkhe->bqhe', p.astype(v.dtype), v)


def gated_merge(oa, ob, oc, g, b_gate, w_branch, w_out):
    ga, gb, gc = jnp.split(jax.nn.sigmoid(g + b_gate), N_BRANCH, axis=-1)
    y = ga * (oa @ w_branch[0]) + gb * (ob @ w_branch[1]) + gc * (oc @ w_branch[2])
    return y @ w_out


def token_mix(hx, hc, w_in, b_gate, ln_v_g, ln_v_b, spatial_w, spatial_b, lam, lam_init, subln_g,
              q_norm_g, w_uq, kv_norm_g, w_ukv, w_branch, w_out, cos_b, sin_b, cos_c, sin_c, ctx_out):
    offsets = [int(o) for o in np.cumsum(IN_SIZES)[:-1]]
    a_x, qb_x, kb_x, vb_x, cq_x, ckv_x, kr_x, g_x = jnp.split(hx @ w_in, offsets, axis=-1)
    a_c, qb_c, kb_c, vb_c, cq_c, ckv_c, kr_c, g_c = jnp.split(hc @ w_in, offsets, axis=-1)

    def diff_heads(q, k, v):
        bsz, L = q.shape[0], q.shape[1]
        return (q.reshape(bsz, L, B_HEADS, 2, B_HEAD_DIM),
                k.reshape(bsz, L, B_HEADS, 2, B_HEAD_DIM),
                v.reshape(bsz, L, B_HEADS, 2 * B_HEAD_DIM))

    def mla_heads(cq, ckv):
        bsz, L = cq.shape[0], cq.shape[1]
        q = (rms_norm(cq, q_norm_g) @ w_uq).reshape(bsz, L, C_HEADS, C_NOPE + C_ROPE)
        kv = (rms_norm(ckv, kv_norm_g) @ w_ukv).reshape(bsz, L, C_HEADS, C_NOPE + C_VDIM)
        return q, kv[..., :C_NOPE], kv[..., C_NOPE:]

    bsz, n = hx.shape[0], hx.shape[1]

    qbx, kbx, vbx = diff_heads(qb_x, kb_x, vb_x)
    rb_cos, rb_sin = cos_b[:, None, None, :], sin_b[:, None, None, :]
    qbx = apply_rope(qbx, rb_cos, rb_sin)
    kbx = apply_rope(kbx, rb_cos, rb_sin)
    qbc, kbc, vbc = diff_heads(qb_c, kb_c, vb_c)
    kb_all = jnp.concatenate([kbc, kbx], axis=1)
    vb_all = jnp.concatenate([vbc, vbx], axis=1)
    ob_x = diff_post(sweep_query_blocks(lambda qb: diff_softmax_attend(qb, kb_all, vb_all, lam), qbx),
                     subln_g, lam_init)

    qcx, kncx, vcx = mla_heads(cq_x, ckv_x)
    qcx = jnp.concatenate([qcx[..., :C_NOPE],
                           apply_rope(qcx[..., C_NOPE:], cos_c[:, None, :], sin_c[:, None, :])], axis=-1)
    krx = apply_rope(kr_x, cos_c, sin_c)
    qcc, kncc, vcc = mla_heads(cq_c, ckv_c)
    kn_all = jnp.concatenate([kncc, kncx], axis=1)
    kr_all = jnp.concatenate([kr_c, krx], axis=1)
    vc_all = jnp.concatenate([vcc, vcx], axis=1)
    oc_x = sweep_query_blocks(lambda qb: mla_attend(qb, kn_all, kr_all, vc_all), qcx).reshape(bsz, n, C_WIDTH)

    oa_x = chunk_spatial_gating(a_x, ln_v_g, ln_v_b, spatial_w, spatial_b)

    out_x = gated_merge(oa_x, ob_x, oc_x, g_x, b_gate, w_branch, w_out)
    if not ctx_out:
        return out_x, None

    ob_c = diff_post(diff_softmax_attend(qbc, kbc, vbc, lam), subln_g, lam_init)
    oc_c = mla_attend(qcc, kncc, kr_c, vcc).reshape(bsz, hc.shape[1], C_WIDTH)
    oa_c = chunk_spatial_gating(a_c, ln_v_g, ln_v_b, spatial_w, spatial_b)
    out_c = gated_merge(oa_c, ob_c, oc_c, g_c, b_gate, w_branch, w_out)
    return out_x, out_c


def setup_inputs(seed: int = 0) -> dict:
    key = jax.random.key(seed)
    ks = jax.random.split(key, 40)
    f32 = jnp.float32

    def nrm(k, shape, fan_in, mult=1.0):
        return jax.random.normal(k, shape, f32) * (mult * fan_in ** -0.5)

    def gain(k, shape):
        return 1.0 + 0.05 * jax.random.normal(k, shape, f32)

    def small(k, shape, s=0.02):
        return s * jax.random.normal(k, shape, f32)

    L = DEPTH
    return {
        "x": jax.random.normal(ks[0], (BATCH, SEQ, D_MODEL), f32),
        "c": jax.random.normal(ks[1], (BATCH, D_MODEL), f32),
        "ctx": jax.random.normal(ks[2], (BATCH, CTX_LEN, D_MODEL), f32),
        "c_ctx": jax.random.normal(ks[3], (D_MODEL,), f32),
        "ada_w": nrm(ks[4], (L, D_MODEL, N_MOD * D_MODEL), D_MODEL, 0.5),
        "ada_b": small(ks[5], (L, N_MOD * D_MODEL)),
        "norm_ffn1": gain(ks[6], (L, D_MODEL)),
        "ffn1_w13": nrm(ks[7], (L, D_MODEL, 2 * D_FF), D_MODEL),
        "ffn1_w2": nrm(ks[8], (L, D_FF, D_MODEL), D_FF),
        "norm_mix": gain(ks[9], (L, D_MODEL)),
        "w_in": nrm(ks[10], (L, D_MODEL, D_IN), D_MODEL),
        "b_gate": small(ks[11], (L, N_BRANCH * D_MODEL), 0.1),
        "ln_v_g": gain(ks[12], (L, A_WIDTH)),
        "ln_v_b": small(ks[13], (L, A_WIDTH)),
        "spatial_w": nrm(ks[14], (L, A_GROUPS, CHUNK, CHUNK), CHUNK, 0.5),
        "spatial_b": gain(ks[15], (L, A_GROUPS, CHUNK)),
        "lambda_q1": small(ks[16], (L, B_HEAD_DIM), 0.1),
        "lambda_k1": small(ks[17], (L, B_HEAD_DIM), 0.1),
        "lambda_q2": small(ks[18], (L, B_HEAD_DIM), 0.1),
        "lambda_k2": small(ks[19], (L, B_HEAD_DIM), 0.1),
        "subln_g": gain(ks[20], (L, 2 * B_HEAD_DIM)),
        "q_norm_g": gain(ks[21], (L, C_Q_RANK)),
        "w_uq": nrm(ks[22], (L, C_Q_RANK, C_HEADS * (C_NOPE + C_ROPE)), C_Q_RANK),
        "kv_norm_g": gain(ks[23], (L, C_KV_RANK)),
        "w_ukv": nrm(ks[24], (L, C_KV_RANK, C_HEADS * (C_NOPE + C_VDIM)), C_KV_RANK),
        "w_branch": nrm(ks[25], (L, N_BRANCH, BRANCH_W, D_MODEL), BRANCH_W),
        "w_out": nrm(ks[26], (L, D_MODEL, D_MODEL), D_MODEL),
        "norm_ffn2": gain(ks[27], (L, D_MODEL)),
        "ffn2_w13": nrm(ks[28], (L, D_MODEL, 2 * D_FF), D_MODEL),
        "ffn2_w2": nrm(ks[29], (L, D_FF, D_MODEL), D_FF),
        "norm_final": gain(ks[30], (D_MODEL,)),
    }


def reference(x, c, ctx, c_ctx, ada_w, ada_b, norm_ffn1, ffn1_w13, ffn1_w2, norm_mix, w_in, b_gate,
              ln_v_g, ln_v_b, spatial_w, spatial_b, lambda_q1, lambda_k1, lambda_q2, lambda_k2, subln_g,
              q_norm_g, w_uq, kv_norm_g, w_ukv, w_branch, w_out, norm_ffn2, ffn2_w13, ffn2_w2, norm_final):
    n = x.shape[1]
    ROWS = n // GRID_W
    cos_b, sin_b = axial_rope_tables(ROWS, B_HEAD_DIM, x.dtype)
    cos_c, sin_c = axial_rope_tables(ROWS, C_ROPE, x.dtype)
    s_lat = jax.nn.silu(c)
    s_ctx = jax.nn.silu(c_ctx)

    for l in range(DEPTH):
        ctx_out = l < DEPTH - 1
        m_x = jnp.split((s_lat @ ada_w[l] + ada_b[l])[:, None, :], N_MOD, axis=-1)
        m_c = jnp.split(s_ctx @ ada_w[l] + ada_b[l], N_MOD, axis=-1)

        x = x + 0.5 * m_x[2] * swiglu(modulate(rms_norm(x, norm_ffn1[l]), m_x[0], m_x[1]), ffn1_w13[l], ffn1_w2[l])
        ctx = ctx + 0.5 * m_c[2] * swiglu(modulate(rms_norm(ctx, norm_ffn1[l]), m_c[0], m_c[1]), ffn1_w13[l], ffn1_w2[l])

        hx = modulate(rms_norm(x, norm_mix[l]), m_x[3], m_x[4])
        hc = modulate(rms_norm(ctx, norm_mix[l]), m_c[3], m_c[4])
        lam_init = 0.8 - 0.6 * math.exp(-0.3 * l)
        lam = (jnp.exp(jnp.sum(lambda_q1[l].astype(jnp.float32) * lambda_k1[l].astype(jnp.float32)))
               - jnp.exp(jnp.sum(lambda_q2[l].astype(jnp.float32) * lambda_k2[l].astype(jnp.float32)))
               + lam_init)
        out_x, out_c = token_mix(hx, hc, w_in[l], b_gate[l], ln_v_g[l], ln_v_b[l], spatial_w[l], spatial_b[l],
                                 lam, lam_init, subln_g[l], q_norm_g[l], w_uq[l], kv_norm_g[l], w_ukv[l],
                                 w_branch[l], w_out[l], cos_b, sin_b, cos_c, sin_c, ctx_out)
        x = x + m_x[5] * out_x

        x = x + 0.5 * m_x[8] * swiglu(modulate(rms_norm(x, norm_ffn2[l]), m_x[6], m_x[7]), ffn2_w13[l], ffn2_w2[l])
        if ctx_out:
            ctx = ctx + m_c[5] * out_c
            ctx = ctx + 0.5 * m_c[8] * swiglu(modulate(rms_norm(ctx, norm_ffn2[l]), m_c[6], m_c[7]), ffn2_w13[l], ffn2_w2[l])

    return rms_norm(x, norm_final)
```

```cpp
#include <hip/hip_runtime.h>
#include <hip/hip_bf16.h>
#include <hip/hip_cooperative_groups.h>
#include <cstdio>
#include <cstdint>
namespace cg = cooperative_groups;

#ifndef REP_GEMM
#define REP_GEMM 1
#endif
#ifndef REP_MLA
#define REP_MLA 1
#endif
#ifndef MK_COOP
#define MK_COOP 1
#endif

using bf16 = __hip_bfloat16;
typedef unsigned short u16;
using bf16x8 = __attribute__((ext_vector_type(8))) short;
using s16x4  = __attribute__((ext_vector_type(4))) short;
using f32x4  = __attribute__((ext_vector_type(4))) float;
using f32x16 = __attribute__((ext_vector_type(16))) float;
using u32x4  = __attribute__((ext_vector_type(4))) unsigned;
using u32x2  = __attribute__((ext_vector_type(2))) unsigned;

constexpr int DM = 1024, NB = 8, SEQ = 4096, CTXL = 256, DFF = 2816, NMOD = 9;
constexpr int R_ALL = 34816;
constexpr int GR = 8704, NGRP = 4, GLAT = 8192;
constexpr int NWIN = 8992, NWINP = 9216;
constexpr float EPS = 1e-6f;
constexpr int NTHR = 512;
constexpr int LDS_BYTES = 136 * 1024;
constexpr int LDS_SPARE = 128 * 1024;

enum { I_X = 0, I_C, I_CTX, I_CCTX, I_ADAW, I_ADAB, I_NFFN1, I_F1W13, I_F1W2, I_NMIX, I_WIN, I_BGATE, I_LNVG, I_LNVB, I_SPW, I_SPB,
       I_LQ1, I_LK1, I_LQ2, I_LK2, I_SUBLN, I_QNG, I_WUQ, I_KVNG, I_WUKV, I_WBR, I_WOUT, I_NFFN2, I_F2W13, I_F2W2, I_NFINAL };

constexpr size_t al256(size_t x) { return (x + 255) / 256 * 256; }
constexpr size_t WS_CTXRES = 0;
constexpr size_t WS_MOD   = WS_CTXRES + (size_t)2048 * 1024 * 4;
constexpr size_t WS_COSB  = WS_MOD + al256((size_t)2 * 9 * 9216 * 4);
constexpr size_t WS_SINB  = WS_COSB + (size_t)4096 * 32 * 4;
constexpr size_t WS_COSC  = WS_SINB + (size_t)4096 * 32 * 4;
constexpr size_t WS_SINC  = WS_COSC + (size_t)4096 * 16 * 4;
constexpr size_t WS_LAM   = WS_SINC + (size_t)4096 * 16 * 4;
constexpr size_t WS_BAR   = WS_LAM + 256;
constexpr size_t WS_XBAR  = WS_BAR + 256;
constexpr size_t WS_W     = WS_XBAR + 16384;
constexpr size_t WO_W13A = 0;
constexpr size_t WO_W2A  = WO_W13A + (size_t)5632 * 1024 * 2;
constexpr size_t WO_W13B = WO_W2A + (size_t)1024 * 2816 * 2;
constexpr size_t WO_W2B  = WO_W13B + (size_t)5632 * 1024 * 2;
constexpr size_t WO_WIN  = WO_W2B + (size_t)1024 * 2816 * 2;
constexpr size_t WO_WUQ  = WO_WIN + (size_t)NWINP * 1024 * 2;
constexpr size_t WO_WUKV = WO_WUQ + (size_t)1536 * 512 * 2;
constexpr size_t WO_WBR  = WO_WUKV + (size_t)2048 * 256 * 2;
constexpr size_t WO_WOUT = WO_WBR + (size_t)3 * 1024 * 1024 * 2;
constexpr size_t W_LAYER = WO_WOUT + (size_t)1024 * 1024 * 2;
constexpr size_t WS_H    = WS_W + 2 * W_LAYER;
constexpr size_t WS_BIG  = WS_H + (size_t)R_ALL * 1024 * 2;
constexpr size_t WS_ACT  = WS_BIG;
constexpr size_t WS_GA   = WS_BIG;
constexpr size_t WS_QB   = WS_GA + (size_t)GR * 2048 * 2;
constexpr size_t WS_KB   = WS_QB + (size_t)GR * 1024 * 2;
constexpr size_t WS_VB   = WS_KB + (size_t)GR * 1024 * 2;
constexpr size_t WS_CQ   = WS_VB + (size_t)GR * 1024 * 2;
constexpr size_t WS_CKV  = WS_CQ + (size_t)GR * 512 * 2;
constexpr size_t WS_KR   = WS_CKV + (size_t)GR * 256 * 2;
constexpr size_t WS_GATES= WS_KR + (size_t)GR * 32 * 2;
constexpr size_t WS_QC   = WS_GATES + (size_t)GR * 3072 * 2;
constexpr size_t WS_KVC  = WS_QC + (size_t)GR * 1536 * 2;
constexpr size_t WS_OC   = WS_KVC + (size_t)GR * 2048 * 2;
constexpr size_t WS_YTMP = WS_OC + (size_t)GR * 1024 * 2;
constexpr size_t WS_SSQ  = WS_YTMP + (size_t)GR * 1024 * 4;
constexpr size_t WS_SSKV = WS_SSQ + (size_t)GR * 16 * 4;
constexpr size_t WS_MIXEND = WS_SSKV + (size_t)GR * 8 * 4;
constexpr size_t WS_Y    = WS_KVC;
constexpr size_t WS_FFNEND = WS_ACT + (size_t)R_ALL * DFF * 2;
constexpr size_t WS_END  = WS_MIXEND > WS_FFNEND ? WS_MIXEND : WS_FFNEND;

struct Params { const float* in[31]; float* out; unsigned char* ws; int ph_lo, ph_hi; };

__device__ __forceinline__ unsigned cvtpk(float lo, float hi) {
  unsigned r; asm volatile("v_cvt_pk_bf16_f32 %0, %1, %2" : "=v"(r) : "v"(lo), "v"(hi)); return r;
}
__device__ __forceinline__ unsigned cvtpk_s(float lo, float hi) {
  unsigned r; asm volatile("s_nop 1\n\tv_cvt_pk_bf16_f32 %0, %1, %2" : "=v"(r) : "v"(lo), "v"(hi)); return r;
}
__device__ __forceinline__ u16 f2bf(float x) { return (u16)(cvtpk_s(x, 0.f) & 0xffffu); }
__device__ __forceinline__ float bf2f(u16 u) { return __uint_as_float(((unsigned)u) << 16); }
__device__ __forceinline__ float bflo(unsigned w) { return __uint_as_float(w << 16); }
__device__ __forceinline__ float bfhi(unsigned w) { return __uint_as_float(w & 0xffff0000u); }
__device__ __forceinline__ float sigmoidf_(float x) { return __builtin_amdgcn_rcpf(1.f + __expf(-x)); }
__device__ __forceinline__ float siluf_(float x) { return x * __builtin_amdgcn_rcpf(1.f + __expf(-x)); }
__device__ __forceinline__ float gelu_tanh(float x) {
  float u = 0.7978845608028654f * (x + 0.044715f * x * x * x);
  float t = 1.f - 2.f * __builtin_amdgcn_rcpf(1.f + __expf(2.f * u));
  return 0.5f * x * (1.f + t);
}

__device__ __forceinline__ int obx() { int t = __builtin_amdgcn_workgroup_id_x(); asm volatile("" : "+s"(t)); return t; }
__device__ __forceinline__ int ogx() { int t = __builtin_amdgcn_grid_size_x() / NTHR; asm volatile("" : "+s"(t)); return t; }
__device__ __forceinline__ int otid() { int t = threadIdx.x; asm volatile("" : "+v"(t)); return t; }
__device__ __forceinline__ float shx(float v, int m) { const int l = otid(); return __int_as_float(__builtin_amdgcn_ds_bpermute(((l ^ m) & 63) << 2, __float_as_int(v))); }
#define DPP_ADD(v, CTRL) ((v) + __int_as_float(__builtin_amdgcn_mov_dpp(__float_as_int(v), CTRL, 0xF, 0xF, true)))
__device__ __forceinline__ float wave_sum(float v) {
  v = DPP_ADD(v, 0xB1); v = DPP_ADD(v, 0x4E); v = DPP_ADD(v, 0x141); v = DPP_ADD(v, 0x140);
  v += shx(v, 16); v += shx(v, 32); return v;
}
struct TileInfo { float* resid; int mi; int t0; bool lat; };
__device__ __forceinline__ TileInfo tile_info(int r, float* out, float* ctxres) {
  TileInfo ti; int g = r / GR; int rr = r - g * GR;
  if (rr < GLAT) { ti.resid = out + (size_t)(g * GLAT + rr) * DM; ti.mi = g * 2 + (rr >> 12); ti.t0 = rr & 4095; ti.lat = true; }
  else { int cr = rr - GLAT; ti.resid = ctxres + (size_t)(g * 512 + cr) * DM; ti.mi = 8; ti.t0 = 0; ti.lat = false; }
  return ti;
}

constexpr int BM = 256, BK = 64, HALF = 128, NXCD = 8, WGM = 8, HT = HALF * BK;
__device__ __forceinline__ int lds_byte(int r, int c) {
  int st = (r >> 4) * 2 + (c >> 5), rr = r & 15, cc = c & 31, ob = rr * 64 + cc * 2;
  return st * 1024 + (ob ^ (((ob >> 9) & 1) << 5));
}
__device__ __forceinline__ void stage_rc(int b, int& R, int& C) {
  int st = b / 1024, sb = b % 1024, swz = sb ^ (((sb >> 9) & 1) << 5);
  R = (st >> 1) * 16 + swz / 64; C = (st & 1) * 32 + (swz % 64) / 2;
}
__device__ __forceinline__ void tile_of(int L, int nM, int nN, int& pm, int& pn) {
  int nwg = nM * nN, wgid = L;
  { int q = nwg / NXCD, r = nwg % NXCD, xcd = wgid % NXCD, off = wgid / NXCD; wgid = (xcd < r ? xcd * (q + 1) : r * (q + 1) + (xcd - r) * q) + off; }
  int nig = WGM * nN, gid = wgid / nig, fm = gid * WGM, gsz = min(nM - fm, WGM);
  pm = fm + ((wgid % nig) % gsz); pn = (wgid % nig) / gsz;
}

typedef f32x4 Acc[2][2][4][2];
#define LAS __attribute__((address_space(3)))
constexpr int HTB = HALF * BK * 2;
struct Unit { const char* A; const char* B; int pm, pn, tag; };

struct GridSched {
  const char* A; const char* B; int nM, nN, G, c; size_t tstep; int xcd; int latonly;
  __device__ __forceinline__ bool next(int i, Unit& u) const {
    const int L = i * G + c; if (L >= nM * nN) return false;
    int pm, pn; if (xcd == 1) tile_of(L, nM, nN, pm, pn); else if (xcd == 2) { const int x = L & 7, jj = L >> 3; pn = x & 3; pm = 2 * jj + (x >> 2); } else { pm = L % nM; pn = L / nM; }
    if (latonly) pm = (pm >> 5) * 34 + (pm & 31);
    u.pm = pm; u.pn = pn; u.tag = 0; u.A = A + (size_t)pm * tstep; u.B = B + (size_t)pn * tstep; return true;
  }
};
struct MergeSched {
  const char* A0; const char* A1; const char* A2; const char* B; int nM, nN, G, c;
  __device__ __forceinline__ bool next(int i, Unit& u) const {
    const int t = i / 3, br = i - t * 3; const int L = t * G + c; if (L >= nM * nN) return false;
    const int x = L & 7, jj = L >> 3; const int pn = x & 3, pm = 2 * jj + (x >> 2);
    const size_t tstep = (size_t)256 * 1024 * 2;
    u.pm = pm; u.pn = pn; u.tag = br; u.A = (br == 0 ? A0 : (br == 1 ? A1 : A2)) + (size_t)pm * tstep; u.B = B + (size_t)br * 1024 * 1024 * 2 + (size_t)pn * tstep; return true;
  }
};

template <class Epi, class Sched>
__device__ __forceinline__ void gemm_phase(LAS unsigned char* lds, const int K, const Sched& S, const Epi& E) {
  const int tid = otid(), wid = __builtin_amdgcn_readfirstlane(tid >> 6), lane = tid & 63, wr = wid >> 2, wc = wid & 3, fr = lane & 15, fq = lane >> 4;
  const int nt = K / BK;
  unsigned voff[2];
  #pragma unroll
  for (int i = 0; i < 2; ++i) { int R, C; stage_rc(tid * 16 + i * 8192, R, C); voff[i] = (unsigned)(R * K + C) * 2u; }
  const size_t kstep = (size_t)(BK * 2);
  const size_t hstep = (size_t)HALF * K * 2;
  const unsigned ldsw = (unsigned)wid * 1024u;
  const int aoff = lds_byte(wr * 64 + fr, fq * 8), boff = lds_byte(wc * 32 + fr, fq * 8);
#define PG8_SA(b, h) (((b) * 2 + (h)) * HTB)
#define PG8_SB(b, h) ((4 + (b) * 2 + (h)) * HTB)
#define PG8_STAGE(bufoff, gbase) do { _Pragma("unroll") for (int _i = 0; _i < 2; ++_i) \
    __builtin_amdgcn_global_load_lds((const unsigned*)((const char*)(gbase) + voff[_i]), (LAS unsigned*)(lds + (bufoff) + ldsw + _i * 8192), 16, 0, 0); } while (0)
#define PG8_LDA(dst, b, h) do { _Pragma("unroll") for (int m = 0; m < 4; ++m) _Pragma("unroll") for (int k = 0; k < 2; ++k) dst[m][k] = *(const LAS bf16x8*)(lds + PG8_SA(b, h) + aoff + m * 2048 + k * 1024); } while (0)
#define PG8_LDB(dst, b, h) do { _Pragma("unroll") for (int n = 0; n < 2; ++n) _Pragma("unroll") for (int k = 0; k < 2; ++k) dst[n][k] = *(const LAS bf16x8*)(lds + PG8_SB(b, h) + boff + n * 2048 + k * 1024); } while (0)
#define PG8_MMA(ai, bj, At, Bt) do { __builtin_amdgcn_s_setprio(1); _Pragma("unroll") for (int m = 0; m < 4; ++m) _Pragma("unroll") for (int n = 0; n < 2; ++n) _Pragma("unroll") for (int k = 0; k < 2; ++k) \
    acc[ai][bj][m][n] = __builtin_amdgcn_mfma_f32_16x16x32_bf16(Bt[n][k], At[m][k], acc[ai][bj][m][n], 0, 0, 0); __builtin_amdgcn_s_setprio(0); } while (0)
#define PG8_WAIT_V(n) asm volatile("s_waitcnt vmcnt(" #n ")" ::: "memory")
#define PG8_WAIT_L(n) asm volatile("s_waitcnt lgkmcnt(" #n ")" ::: "memory")
#define PG8_BAR __builtin_amdgcn_s_barrier()
#define PG8_SCHED __builtin_amdgcn_sched_barrier(0)
  Unit cur, nxt; int ui = 0;
  if (!S.next(0, cur)) return;
  f32x4 acc[2][2][4][2];
  float zz = 0.f; asm volatile("" : "+v"(zz));
  #pragma unroll
  for (int a = 0; a < 2; ++a)
  #pragma unroll
  for (int b = 0; b < 2; ++b)
  #pragma unroll
  for (int m = 0; m < 4; ++m)
  #pragma unroll
  for (int n = 0; n < 2; ++n) acc[a][b][m][n] = (f32x4){zz, zz, zz, zz};
  bf16x8 At[4][2], B0[2][2], B1[2][2];
  const char* cA = cur.A; const char* cB = cur.B;
  __builtin_amdgcn_s_waitcnt(0x0F70);
  PG8_STAGE(PG8_SB(0, 0), cB); PG8_STAGE(PG8_SA(0, 0), cA); PG8_STAGE(PG8_SB(0, 1), cB + hstep); PG8_STAGE(PG8_SA(0, 1), cA + hstep);
  if (wr == 1) PG8_BAR;
  PG8_WAIT_V(4); PG8_BAR;
  PG8_STAGE(PG8_SB(1, 0), cB + kstep); PG8_STAGE(PG8_SA(1, 0), cA + kstep); PG8_STAGE(PG8_SB(1, 1), cB + hstep + kstep);
  PG8_WAIT_V(6); PG8_BAR;
  for (;;) {
    const bool has_next = S.next(ui + 1, nxt);
    const char* nA = has_next ? nxt.A : cA; const char* nB = has_next ? nxt.B : cB;
    for (int t = 0; t < nt; t += 2) {
      const bool last = (t == nt - 2);
      const char* a1 = cA + (size_t)(t + 1) * kstep;
      const char* a2 = last ? nA : cA + (size_t)(t + 2) * kstep; const char* b2 = last ? nB : cB + (size_t)(t + 2) * kstep;
      const char* a3 = a2 + kstep; const char* b3 = b2 + kstep;
      PG8_LDB(B0, 0, 0); PG8_SCHED; PG8_LDA(At, 0, 0); PG8_STAGE(PG8_SA(1, 1), a1 + hstep);
      PG8_WAIT_L(8); PG8_BAR; PG8_WAIT_L(0); PG8_MMA(0, 0, At, B0); PG8_BAR; PG8_SCHED;
      PG8_LDB(B1, 0, 1); PG8_STAGE(PG8_SB(0, 0), b2);
      PG8_BAR; PG8_WAIT_L(0); PG8_MMA(0, 1, At, B1); PG8_BAR;
      PG8_LDA(At, 0, 1); PG8_STAGE(PG8_SA(0, 0), a2);
      PG8_BAR; PG8_WAIT_L(0); PG8_MMA(1, 0, At, B0); PG8_BAR; PG8_SCHED;
      PG8_STAGE(PG8_SB(0, 1), b2 + hstep);
      PG8_WAIT_V(6); PG8_BAR; PG8_MMA(1, 1, At, B1); PG8_BAR;
      PG8_LDB(B0, 1, 0); PG8_SCHED; PG8_LDA(At, 1, 0); PG8_STAGE(PG8_SA(0, 1), a2 + hstep);
      PG8_WAIT_L(8); PG8_BAR; PG8_WAIT_L(0); PG8_MMA(0, 0, At, B0); PG8_BAR; PG8_SCHED;
      PG8_LDB(B1, 1, 1); PG8_STAGE(PG8_SB(1, 0), b3);
      PG8_BAR; PG8_WAIT_L(0); PG8_MMA(0, 1, At, B1); PG8_BAR;
      PG8_LDA(At, 1, 1); PG8_STAGE(PG8_SA(1, 0), a3);
      PG8_BAR; PG8_WAIT_L(0); PG8_MMA(1, 0, At, B0); PG8_BAR; PG8_SCHED;
      PG8_STAGE(PG8_SB(1, 1), b3 + hstep);
      PG8_WAIT_V(6); PG8_BAR; PG8_MMA(1, 1, At, B1); PG8_BAR;
    }
    { const int t2 = otid(), l2 = t2 & 63; E.apply(acc, cur, wr, wc, l2 & 15, l2 >> 4); }
    if (!has_next) break;
    __builtin_amdgcn_s_waitcnt(0x0F70);
    #pragma unroll
    for (int a = 0; a < 2; ++a)
    #pragma unroll
    for (int b = 0; b < 2; ++b)
    #pragma unroll
    for (int m = 0; m < 4; ++m)
    #pragma unroll
    for (int n = 0; n < 2; ++n) acc[a][b][m][n] = (f32x4){zz, zz, zz, zz};
    cur = nxt; cA = nA; cB = nB; ++ui;
  }
  PG8_WAIT_V(0);
  if (wr == 0) PG8_BAR;
  PG8_BAR;
#undef PG8_SA
#undef PG8_SB
#undef PG8_STAGE
#undef PG8_LDA
#undef PG8_LDB
#undef PG8_MMA
#undef PG8_WAIT_V
#undef PG8_WAIT_L
#undef PG8_BAR
#undef PG8_SCHED
}

__device__ __forceinline__ void st4bf(bf16* p, f32x4 v) {
  u32x2 w = {cvtpk_s(v[0], v[1]), cvtpk_s(v[2], v[3])}; *reinterpret_cast<u32x2*>(p) = w;
}

struct EpiSwiglu {
  bf16* act;
  __device__ __forceinline__ void apply(Acc& acc, const Unit& u, int wr, int wc, int fr, int fq) const {
    const int brow = u.pm * 256, bcol = u.pn * 256;
    const int cb = (bcol >> 1) + wc * 32 + fq * 4;
    #pragma unroll
    for (int ai = 0; ai < 2; ++ai)
    #pragma unroll
    for (int m = 0; m < 4; ++m) {
      const size_t row = brow + ai * 128 + wr * 64 + m * 16 + fr;
      #pragma unroll
      for (int n = 0; n < 2; ++n) {
        f32x4 a = acc[ai][0][m][n], b = acc[ai][1][m][n], v;
        #pragma unroll
        for (int j = 0; j < 4; ++j) v[j] = siluf_(a[j]) * b[j];
        st4bf(act + row * DFF + cb + n * 16, v);
      }
    }
  }
};
struct EpiResid {
  float* out; float* ctxres; const float* gate; float coef; int row0; int dry; const float* src_lat; const float* src_ctx;
  __device__ __forceinline__ void apply(Acc& acc, const Unit& u, int wr, int wc, int fr, int fq) const {
    const int brow = u.pm * 256, bcol = u.pn * 256;
    TileInfo ti = tile_info(row0 + brow, out, ctxres);
    const float* srcb = tile_info(row0 + brow, const_cast<float*>(src_lat), const_cast<float*>(src_ctx)).resid;
    const float* g = gate + (size_t)ti.mi * 9216;
    #pragma unroll
    for (int bj = 0; bj < 2; ++bj)
    #pragma unroll
    for (int n = 0; n < 2; ++n) {
      const int col = bcol + bj * 128 + wc * 32 + n * 16 + fq * 4;
      f32x4 gv = *(const __attribute__((address_space(1))) f32x4*)(g + col);
      #pragma unroll
      for (int ai = 0; ai < 2; ++ai)
      #pragma unroll
      for (int m = 0; m < 4; ++m) {
        float* p = ti.resid + (size_t)(ai * 128 + wr * 64 + m * 16 + fr) * DM + col;
        f32x4 x = *(const __attribute__((address_space(1))) f32x4*)(srcb + (size_t)(ai * 128 + wr * 64 + m * 16 + fr) * DM + col);
        #pragma unroll
        for (int j = 0; j < 4; ++j) x[j] += coef * gv[j] * acc[ai][bj][m][n][j];
        if (!dry) *(__attribute__((address_space(1))) f32x4*)(p) = x;
      }
    }
  }
};
struct EpiWin {
  unsigned char* ws; const float* bgate; int row0;
  __device__ __forceinline__ void apply(Acc& acc, const Unit& u, int wr, int wc, int fr, int fq) const {
    const int brow = u.pm * 256, bcol = u.pn * 256;
    TileInfo ti = tile_info(row0 + brow, nullptr, nullptr);
    const float* cosb = (const float*)(ws + WS_COSB); const float* sinb = (const float*)(ws + WS_SINB);
    const float* cosc = (const float*)(ws + WS_COSC); const float* sinc = (const float*)(ws + WS_SINC);
    #pragma unroll
    for (int bj = 0; bj < 2; ++bj) {
      const int c0 = bcol + bj * 128 + wc * 32;
      if (c0 >= NWIN) continue;
      if (c0 < 2048) {
        bf16* ga = (bf16*)(ws + WS_GA);
        #pragma unroll
        for (int ai = 0; ai < 2; ++ai)
        #pragma unroll
        for (int m = 0; m < 4; ++m) {
          const size_t row = brow + ai * 128 + wr * 64 + m * 16 + fr;
          #pragma unroll
          for (int n = 0; n < 2; ++n) { f32x4 v;
            #pragma unroll
            for (int j = 0; j < 4; ++j) v[j] = gelu_tanh(acc[ai][bj][m][n][j]);
            st4bf(ga + row * 2048 + c0 + n * 16 + fq * 4, v); }
        }
      } else if (c0 < 4096) {
        bf16* dst = (bf16*)(ws + (c0 < 3072 ? WS_QB : WS_KB));
        const int cc = (c0 - (c0 < 3072 ? 2048 : 3072));
        const int f0 = ((c0 >> 5) & 1) * 16 + fq * 4;
        #pragma unroll
        for (int ai = 0; ai < 2; ++ai)
        #pragma unroll
        for (int m = 0; m < 4; ++m) {
          const int rl = ai * 128 + wr * 64 + m * 16 + fr;
          const size_t row = brow + rl;
          f32x4 x1 = acc[ai][bj][m][0], x2 = acc[ai][bj][m][1], y1, y2;
          if (ti.lat) {
            const int t = ti.t0 + rl;
            f32x4 cs = *reinterpret_cast<const f32x4*>(cosb + t * 32 + f0), sn = *reinterpret_cast<const f32x4*>(sinb + t * 32 + f0);
            #pragma unroll
            for (int j = 0; j < 4; ++j) { y1[j] = x1[j] * cs[j] - x2[j] * sn[j]; y2[j] = x2[j] * cs[j] + x1[j] * sn[j]; }
          } else { y1 = x1; y2 = x2; }
          st4bf(dst + row * 1024 + cc + fq * 4, y1); st4bf(dst + row * 1024 + cc + 16 + fq * 4, y2);
        }
      } else if (c0 < 5120) {
        bf16* dst = (bf16*)(ws + WS_VB);
        #pragma unroll
        for (int ai = 0; ai < 2; ++ai)
        #pragma unroll
        for (int m = 0; m < 4; ++m) {
          const size_t row = brow + ai * 128 + wr * 64 + m * 16 + fr;
          #pragma unroll
          for (int n = 0; n < 2; ++n) st4bf(dst + row * 1024 + (c0 - 4096) + n * 16 + fq * 4, acc[ai][bj][m][n]);
        }
      } else if (c0 < 5888) {
        const bool isq = c0 < 5632;
        bf16* dst = (bf16*)(ws + (isq ? WS_CQ : WS_CKV));
        float* ss = (float*)(ws + (isq ? WS_SSQ : WS_SSKV));
        const int cc = c0 - (isq ? 5120 : 5632), ld = isq ? 512 : 256, nch = isq ? 16 : 8;
        #pragma unroll
        for (int ai = 0; ai < 2; ++ai)
        #pragma unroll
        for (int m = 0; m < 4; ++m) {
          const size_t row = brow + ai * 128 + wr * 64 + m * 16 + fr;
          float s = 0.f;
          #pragma unroll
          for (int n = 0; n < 2; ++n) {
            f32x4 v = acc[ai][bj][m][n];
            #pragma unroll
            for (int j = 0; j < 4; ++j) s += v[j] * v[j];
            st4bf(dst + row * ld + cc + n * 16 + fq * 4, v);
          }
          s += shx(s, 16); s += shx(s, 32);
          if (fq == 0) ss[row * nch + (cc >> 5)] = s;
        }
      } else if (c0 < 5920) {
        bf16* dst = (bf16*)(ws + WS_KR);
        #pragma unroll
        for (int ai = 0; ai < 2; ++ai)
        #pragma unroll
        for (int m = 0; m < 4; ++m) {
          const int rl = ai * 128 + wr * 64 + m * 16 + fr;
          const size_t row = brow + rl;
          f32x4 x1 = acc[ai][bj][m][0], x2 = acc[ai][bj][m][1], y1, y2;
          if (ti.lat) {
            const int t = ti.t0 + rl;
            f32x4 cs = *reinterpret_cast<const f32x4*>(cosc + t * 16 + fq * 4), sn = *reinterpret_cast<const f32x4*>(sinc + t * 16 + fq * 4);
            #pragma unroll
            for (int j = 0; j < 4; ++j) { y1[j] = x1[j] * cs[j] - x2[j] * sn[j]; y2[j] = x2[j] * cs[j] + x1[j] * sn[j]; }
          } else { y1 = x1; y2 = x2; }
          st4bf(dst + row * 32 + fq * 4, y1); st4bf(dst + row * 32 + 16 + fq * 4, y2);
        }
      } else {
        bf16* dst = (bf16*)(ws + WS_GATES);
        const int cc = c0 - 5920;
        #pragma unroll
        for (int n = 0; n < 2; ++n) {
          f32x4 bg = *reinterpret_cast<const f32x4*>(bgate + cc + n * 16 + fq * 4);
          #pragma unroll
          for (int ai = 0; ai < 2; ++ai)
          #pragma unroll
          for (int m = 0; m < 4; ++m) {
            const size_t row = brow + ai * 128 + wr * 64 + m * 16 + fr; f32x4 v;
            #pragma unroll
            for (int j = 0; j < 4; ++j) v[j] = sigmoidf_(acc[ai][bj][m][n][j] + bg[j]);
            st4bf(dst + row * 3072 + cc + n * 16 + fq * 4, v);
          }
        }
      }
    }
  }
};
template <int isq> struct EpiUp {
  unsigned char* ws; int row0;
  __device__ __forceinline__ void apply(Acc& acc, const Unit& u, int wr, int wc, int fr, int fq) const {
    const int brow = u.pm * 256, bcol = u.pn * 256;
    TileInfo ti = tile_info(row0 + brow, nullptr, nullptr);
    const float* cosc = (const float*)(ws + WS_COSC); const float* sinc = (const float*)(ws + WS_SINC);
    bf16* dst = (bf16*)(ws + (isq ? WS_QC : WS_KVC)); const int ld = isq ? 1536 : 2048;
    float rinv[2][4];
    { f32x4 pv[2][4];
      #pragma unroll
      for (int ai = 0; ai < 2; ++ai)
      #pragma unroll
      for (int m = 0; m < 4; ++m) {
        const size_t row = brow + ai * 128 + wr * 64 + m * 16 + fr;
        if (isq) pv[ai][m] = reinterpret_cast<const f32x4*>((const float*)(ws + WS_SSQ) + row * 16)[fq];
        else pv[ai][m] = reinterpret_cast<const f32x4*>((const float*)(ws + WS_SSKV) + row * 8)[fq & 1];
      }
      #pragma unroll
      for (int ai = 0; ai < 2; ++ai)
      #pragma unroll
      for (int m = 0; m < 4; ++m) {
        float sm = pv[ai][m][0] + pv[ai][m][1] + pv[ai][m][2] + pv[ai][m][3];
        if (!isq && fq >= 2) sm = 0.f;
        sm += shx(sm, 16); sm += shx(sm, 32);
        rinv[ai][m] = rsqrtf(sm * (isq ? 1.f / 512.f : 1.f / 256.f) + EPS);
      } }
    #pragma unroll
    for (int ai = 0; ai < 2; ++ai)
    #pragma unroll
    for (int m = 0; m < 4; ++m) {
      const int rl = ai * 128 + wr * 64 + m * 16 + fr;
      const size_t row = brow + rl; const float ri = rinv[ai][m];
      #pragma unroll
      for (int bj = 0; bj < 2; ++bj) {
        const int c0 = bcol + bj * 128 + wc * 32;
        const bool rope = isq && ((c0 >> 5) % 3 == 2) && ti.lat;
        f32x4 x1 = acc[ai][bj][m][0], x2 = acc[ai][bj][m][1], y1, y2;
        #pragma unroll
        for (int j = 0; j < 4; ++j) { x1[j] *= ri; x2[j] *= ri; }
        if (rope) {
          const int t = ti.t0 + rl;
          f32x4 cs = *reinterpret_cast<const f32x4*>(cosc + t * 16 + fq * 4), sn = *reinterpret_cast<const f32x4*>(sinc + t * 16 + fq * 4);
          #pragma unroll
          for (int j = 0; j < 4; ++j) { y1[j] = x1[j] * cs[j] - x2[j] * sn[j]; y2[j] = x2[j] * cs[j] + x1[j] * sn[j]; }
        } else { y1 = x1; y2 = x2; }
        st4bf(dst + row * ld + c0 + fq * 4, y1); st4bf(dst + row * ld + c0 + 16 + fq * 4, y2);
      }
    }
  }
};
struct EpiMerge {
  unsigned char* ws;
  __device__ __forceinline__ void apply(Acc& acc, const Unit& u, int wr, int wc, int fr, int fq) const {
    const int brow = u.pm * 256, bcol = u.pn * 256;
    const int br = u.tag;
    const bf16* gates = (const bf16*)(ws + WS_GATES); float* ytmp = (float*)(ws + WS_YTMP); bf16* y = (bf16*)(ws + WS_Y);
    #pragma unroll
    for (int bj = 0; bj < 2; ++bj)
    #pragma unroll
    for (int n = 0; n < 2; ++n) {
      const int col = bcol + bj * 128 + wc * 32 + n * 16 + fq * 4;
      #pragma unroll
      for (int ai = 0; ai < 2; ++ai)
      #pragma unroll
      for (int m = 0; m < 4; ++m) {
        const size_t row = brow + ai * 128 + wr * 64 + m * 16 + fr;
        u32x2 gw = *reinterpret_cast<const u32x2*>(gates + row * 3072 + br * 1024 + col);
        f32x4 a = acc[ai][bj][m][n], v;
        v[0] = bflo(gw[0]) * a[0]; v[1] = bfhi(gw[0]) * a[1]; v[2] = bflo(gw[1]) * a[2]; v[3] = bfhi(gw[1]) * a[3];
        float* p = ytmp + row * 1024 + col;
        if (br > 0) { f32x4 o = *reinterpret_cast<f32x4*>(p); v[0] += o[0]; v[1] += o[1]; v[2] += o[2]; v[3] += o[3]; }
        if (br < 2) *reinterpret_cast<f32x4*>(p) = v; else st4bf(y + row * 1024 + col, v);
      }
    }
  }
};

#define KSWZ(row, colB) ((row) * 256 + ((colB) ^ (((row) & 7) << 4)))
#define SBAR() __builtin_amdgcn_sched_barrier(0)
constexpr int KVBLK = 64;
constexpr int SHM_V = KVBLK * 128 * 2, SHM_K = KVBLK * 128 * 2;
constexpr float ATT_THR = 8.f;
__device__ __forceinline__ int crow(int r, int hi) { return (r & 3) + 8 * (r >> 2) + 4 * hi; }

template <int MODE> struct ACfg;
template <> struct ACfg<0> { static constexpr int ND0 = 4, NDV = 4; static constexpr float SCALE = 0.125f; };
template <> struct ACfg<1> { static constexpr int ND0 = 6, NDV = 2; static constexpr float SCALE = 0.10206207261596575f; };

template <int MODE>
__device__ __forceinline__ void partialSM(f32x16& p0, f32x16& p1, float& m_reg, float& mn, float& alpha) {
  constexpr float SC = ACfg<MODE>::SCALE;
  constexpr float C = SC * 1.4426950408889634f;
  float pmax = p0[0];
  #pragma unroll
  for (int r = 1; r < 16; ++r) pmax = fmaxf(pmax, p0[r]);
  #pragma unroll
  for (int r = 0; r < 16; ++r) pmax = fmaxf(pmax, p1[r]);
  { auto rr = __builtin_amdgcn_permlane32_swap(__float_as_uint(pmax), __float_as_uint(pmax), false, false);
    pmax = fmaxf(__uint_as_float(rr[0]), __uint_as_float(rr[1])); }
  if (__builtin_expect(__all(pmax - m_reg <= ATT_THR / SC), 1)) { mn = m_reg; alpha = 1.f; }
  else { mn = fmaxf(m_reg, pmax); alpha = __builtin_amdgcn_exp2f((m_reg - mn) * C); m_reg = mn; }
  float mnC = -mn * C;
  #pragma unroll
  for (int r = 0; r < 16; ++r) p0[r] = fmaf(p0[r], C, mnC);
  #pragma unroll
  for (int r = 0; r < 16; ++r) p1[r] = fmaf(p1[r], C, mnC);
  #pragma unroll
  for (int r = 0; r < 16; ++r) p0[r] = __builtin_amdgcn_exp2f(p0[r]);
}
template <bool SUM>
__device__ __forceinline__ void finishSM(f32x16& p0, f32x16& p1, float alpha, float& l_reg, bf16x8& pa0, bf16x8& pa1, bf16x8& pa2, bf16x8& pa3) {
  #pragma unroll
  for (int r = 0; r < 16; ++r) p1[r] = __builtin_amdgcn_exp2f(p1[r]);
  if constexpr (SUM) {
    float ps = 0;
    #pragma unroll
    for (int r = 0; r < 16; ++r) ps += p0[r];
    #pragma unroll
    for (int r = 0; r < 16; ++r) ps += p1[r];
    { auto rr = __builtin_amdgcn_permlane32_swap(__float_as_uint(ps), __float_as_uint(ps), false, false);
      ps = __uint_as_float(rr[0]) + __uint_as_float(rr[1]); }
    l_reg = l_reg * alpha + ps;
  }
#define PK4(P, BASE, OUT) do { unsigned a0 = cvtpk(P[BASE + 0], P[BASE + 1]), a1 = cvtpk(P[BASE + 2], P[BASE + 3]);   \
    unsigned b0 = cvtpk(P[BASE + 4], P[BASE + 5]), b1 = cvtpk(P[BASE + 6], P[BASE + 7]);                              \
    auto r0 = __builtin_amdgcn_permlane32_swap(a0, b0, false, false); auto r1 = __builtin_amdgcn_permlane32_swap(a1, b1, false, false); \
    u32x4 w = {r0[0], r1[0], r0[1], r1[1]}; OUT = *reinterpret_cast<bf16x8*>(&w); } while (0)
  PK4(p0, 0, pa0); PK4(p0, 8, pa1); PK4(p1, 0, pa2); PK4(p1, 8, pa3);
#undef PK4
}
template <int MODE>
__device__ __forceinline__ void qkt(f32x16& p0, f32x16& p1, const char* Ks, const bf16x8* qr, int r32, int hi) {
  p0 = f32x16{}; p1 = f32x16{};
  #pragma unroll
  for (int d0 = 0; d0 < ACfg<MODE>::ND0; ++d0) { int cb = (d0 * 16 + hi * 8) * 2;
    bf16x8 b0 = *reinterpret_cast<const bf16x8*>(Ks + KSWZ(r32, cb));
    bf16x8 b1 = *reinterpret_cast<const bf16x8*>(Ks + KSWZ(32 + r32, cb));
    p0 = __builtin_amdgcn_mfma_f32_32x32x16_bf16(b0, qr[d0], p0, 0, 0, 0);
    p1 = __builtin_amdgcn_mfma_f32_32x32x16_bf16(b1, qr[d0], p1, 0, 0, 0); }
}
__device__ __forceinline__ int v_st(int k, int c) { const int kk = (k & ~0xC) | ((k & 4) << 1) | ((k & 8) >> 1); return ((kk >> 3) * 4 + (c >> 5)) * 512 + ((kk & 7) * 32 + (c & 31)) * 2; }
__device__ __forceinline__ int v_rd_base(int lane) { return ((lane & 3) << 3) | (((lane >> 2) & 3) << 6) | (((lane >> 4) & 1) << 5) | (((lane >> 5) & 1) << 8); }
constexpr int v_rd_off(int d0, int ks, int half) { return d0 * 512 + ks * 4096 + half * 2048; }
template <int OFF> __device__ __forceinline__ s16x4 tr_read(int vb) {
  s16x4 r; asm volatile("ds_read_b64_tr_b16 %0, %1 offset:%2" : "=&v"(r) : "v"(vb), "i"(OFF) : "memory"); return r;
}
template <int D0> __device__ __forceinline__ void pv_one(f32x16& od, int vb, bf16x8 pa0, bf16x8 pa1, bf16x8 pa2, bf16x8 pa3) {
  const s16x4 l0 = tr_read<v_rd_off(D0, 0, 0)>(vb), h0 = tr_read<v_rd_off(D0, 0, 1)>(vb), l1 = tr_read<v_rd_off(D0, 1, 0)>(vb), h1 = tr_read<v_rd_off(D0, 1, 1)>(vb);
  const s16x4 l2 = tr_read<v_rd_off(D0, 2, 0)>(vb), h2 = tr_read<v_rd_off(D0, 2, 1)>(vb), l3 = tr_read<v_rd_off(D0, 3, 0)>(vb), h3 = tr_read<v_rd_off(D0, 3, 1)>(vb);
  asm volatile("s_waitcnt lgkmcnt(0)" ::: "memory"); SBAR();
#define PK(L, H) (bf16x8){L[0], L[1], L[2], L[3], H[0], H[1], H[2], H[3]}
  od = __builtin_amdgcn_mfma_f32_32x32x16_bf16(pa0, PK(l0, h0), od, 0, 0, 0);
  od = __builtin_amdgcn_mfma_f32_32x32x16_bf16(pa1, PK(l1, h1), od, 0, 0, 0);
  od = __builtin_amdgcn_mfma_f32_32x32x16_bf16(pa2, PK(l2, h2), od, 0, 0, 0);
  od = __builtin_amdgcn_mfma_f32_32x32x16_bf16(pa3, PK(l3, h3), od, 0, 0, 0);
#undef PK
}
template <int MODE>
__device__ __forceinline__ void pv_all(f32x16* o, int vb, bf16x8 pa0, bf16x8 pa1, bf16x8 pa2, bf16x8 pa3) {
  pv_one<0>(o[0], vb, pa0, pa1, pa2, pa3); pv_one<1>(o[1], vb, pa0, pa1, pa2, pa3);
  if constexpr (ACfg<MODE>::NDV == 4) { pv_one<2>(o[2], vb, pa0, pa1, pa2, pa3); pv_one<3>(o[3], vb, pa0, pa1, pa2, pa3); }
  {
    constexpr int LS = ACfg<MODE>::NDV;
    const bf16x8 ones = {16256, 16256, 16256, 16256, 16256, 16256, 16256, 16256};
    o[LS] = __builtin_amdgcn_mfma_f32_32x32x16_bf16(pa0, ones, o[LS], 0, 0, 0);
    o[LS] = __builtin_amdgcn_mfma_f32_32x32x16_bf16(pa1, ones, o[LS], 0, 0, 0);
    o[LS] = __builtin_amdgcn_mfma_f32_32x32x16_bf16(pa2, ones, o[LS], 0, 0, 0);
    o[LS] = __builtin_amdgcn_mfma_f32_32x32x16_bf16(pa3, ones, o[LS], 0, 0, 0);
  }
}

template <int MODE>
__device__ __forceinline__ void attn_body(const bf16* __restrict__ Qb, const bf16* __restrict__ Kp, const bf16* __restrict__ Kr, const bf16* __restrict__ Vp,
                                          int lat_row, int ctx_row, int nt_lat, int NT, f32x16* o, float& l_out, char* lds) {
  constexpr int ND0 = ACfg<MODE>::ND0, NDV = ACfg<MODE>::NDV, NACC = NDV + 1;
  constexpr int LDQ = MODE ? 1536 : 1024, LDK = MODE ? 2048 : 1024;
  const int tid = otid(), wid = tid >> 6, lane = tid & 63, r32 = lane & 31, hi = lane >> 5;
  char* V_lds = lds; char* K_lds = lds + 2 * SHM_V;
  float* wsl = (float*)(lds + 2 * SHM_V + 2 * SHM_K) + wid * 64; float* al_l = wsl + 32;
  float m_reg = -1e30f, l_reg = 0;
  #pragma unroll
  for (int d = 0; d < NACC; ++d) { float zz = 0.f; asm volatile("" : "+v"(zz));
    _Pragma("unroll") for (int r = 0; r < 16; ++r) o[d][r] = zz; }
  bf16x8 qr[ND0];
  const bf16* Qw = Qb + (size_t)(wid * 32 + r32) * LDQ + hi * 8;
  #pragma unroll
  for (int d0 = 0; d0 < ND0; ++d0) qr[d0] = *reinterpret_cast<const bf16x8*>(Qw + d0 * 16);
  const int vb0 = (int)(uintptr_t)V_lds + v_rd_base(lane);
  const int kkey = tid >> 3, kpc = tid & 7;
  const int sr = tid >> 4, sc = (tid & 15) * 8;
  const int rkey = (tid >> 2) & 63, rpc = tid & 3;
  const int ks_off = KSWZ(kkey, kpc * 16), kr_off = KSWZ(rkey, 128 + rpc * 16);
  const int vst0 = MODE ? v_st(kkey, kpc * 8) : v_st(sr, sc), vst1 = v_st(32 + sr, sc);
  bf16x8 sa0, sb0, sc0, sa1, sb1, sc1;
#define KROW(j) ((j) < nt_lat ? lat_row + (j) * 64 : ctx_row + ((j) - nt_lat) * 64)
#define SLOAD(A_, B_, C_, j) do { const int kr0 = KROW(j); \
    if constexpr (MODE == 0) { A_ = *reinterpret_cast<const bf16x8*>(Kp + (size_t)(kr0 + kkey) * LDK + kpc * 8); \
      B_ = *reinterpret_cast<const bf16x8*>(Vp + (size_t)(kr0 + sr) * LDK + sc); C_ = *reinterpret_cast<const bf16x8*>(Vp + (size_t)(kr0 + 32 + sr) * LDK + sc); } \
    else { A_ = *reinterpret_cast<const bf16x8*>(Kp + (size_t)(kr0 + kkey) * LDK + kpc * 8); \
      B_ = *reinterpret_cast<const bf16x8*>(Vp + (size_t)(kr0 + kkey) * LDK + kpc * 8); C_ = *reinterpret_cast<const bf16x8*>(Kr + (size_t)(kr0 + rkey) * 32 + rpc * 8); } } while (0)
#define SWRITE(b, A_, B_, C_) do { *reinterpret_cast<bf16x8*>(K_lds + (b) * SHM_K + ks_off) = A_; \
    if constexpr (MODE == 0) { *reinterpret_cast<bf16x8*>(V_lds + (b) * SHM_V + vst0) = B_; *reinterpret_cast<bf16x8*>(V_lds + (b) * SHM_V + vst1) = C_; } \
    else { *reinterpret_cast<bf16x8*>(V_lds + (b) * SHM_V + vst0) = B_; *reinterpret_cast<bf16x8*>(K_lds + (b) * SHM_K + kr_off) = C_; } } while (0)
#define SWAIT() asm volatile("s_waitcnt vmcnt(3)" ::: "memory")
#define RESC(a) do { if (__any((a) < 1.f)) { if (hi == 0) al_l[r32] = (a); asm volatile("s_waitcnt lgkmcnt(0)" ::: "memory"); \
    _Pragma("unroll") for (int d = 0; d < NACC; ++d) _Pragma("unroll") for (int r = 0; r < 16; ++r) o[d][r] *= al_l[crow(r, hi)]; } } while (0)
  f32x16 pA0, pA1, pB0, pB1; float mnA, mnB, alA, alB; bf16x8 pa0, pa1, pa2, pa3;
  SLOAD(sa0, sb0, sc0, 0); asm volatile("s_waitcnt vmcnt(0)" ::: "memory"); SWRITE(0, sa0, sb0, sc0); __syncthreads();
  qkt<MODE>(pA0, pA1, K_lds, qr, r32, hi); partialSM<MODE>(pA0, pA1, m_reg, mnA, alA);
  SLOAD(sa1, sb1, sc1, 1); if (2 < NT) SLOAD(sa0, sb0, sc0, 2);
  SWAIT(); SWRITE(1, sa1, sb1, sc1); __syncthreads();
  for (int j = 1; j + 1 < NT; j += 2) {
    SBAR(); qkt<MODE>(pB0, pB1, K_lds + SHM_K, qr, r32, hi);
    finishSM<false>(pA0, pA1, alA, l_reg, pa0, pa1, pa2, pa3); SBAR();
    SLOAD(sa1, sb1, sc1, j + 2); SBAR();
    pv_all<MODE>(o, vb0, pa0, pa1, pa2, pa3); partialSM<MODE>(pB0, pB1, m_reg, mnB, alB);
    __syncthreads(); SWAIT(); SWRITE(0, sa0, sb0, sc0);
    RESC(alB); __syncthreads();
    SBAR(); qkt<MODE>(pA0, pA1, K_lds, qr, r32, hi);
    finishSM<false>(pB0, pB1, alB, l_reg, pa0, pa1, pa2, pa3); SBAR();
    if (j + 3 < NT) SLOAD(sa0, sb0, sc0, j + 3); SBAR();
    pv_all<MODE>(o, vb0 + SHM_V, pa0, pa1, pa2, pa3); partialSM<MODE>(pA0, pA1, m_reg, mnA, alA);
    __syncthreads(); SWAIT(); SWRITE(1, sa1, sb1, sc1);
    RESC(alA); __syncthreads();
  }
  SBAR(); qkt<MODE>(pB0, pB1, K_lds + SHM_K, qr, r32, hi);
  finishSM<false>(pA0, pA1, alA, l_reg, pa0, pa1, pa2, pa3); SBAR();
  pv_all<MODE>(o, vb0, pa0, pa1, pa2, pa3); partialSM<MODE>(pB0, pB1, m_reg, mnB, alB);
  __syncthreads(); RESC(alB);
  finishSM<false>(pB0, pB1, alB, l_reg, pa0, pa1, pa2, pa3); SBAR();
  pv_all<MODE>(o, vb0 + SHM_V, pa0, pa1, pa2, pa3);
  l_out = l_reg;
  __syncthreads();
#undef KROW
#undef SLOAD
#undef SWRITE
#undef SWAIT
#undef RESC
}

__device__ __forceinline__ void diff_unit(unsigned char* ws, int qrow0, int h, int lat_row, int ctx_row, int nt_lat, int NT,
                                          float lam, float oscale, const float* subln, char* lds, bool dry = false) {
  const int tid = otid(), wid = tid >> 6, lane = tid & 63, r32 = lane & 31, hi = lane >> 5;
  bf16* qb = (bf16*)(ws + WS_QB); const bf16* kb = (const bf16*)(ws + WS_KB); const bf16* vb = (const bf16*)(ws + WS_VB);
  float* stash = (float*)(ws + WS_YTMP);
  float* li_l = (float*)(lds + 2 * SHM_V + 2 * SHM_K) + wid * 64;
  #pragma unroll 1
  for (int mp = 0; mp < 2; ++mp) {
    f32x16 o[5]; float l_reg;
    attn_body<0>(qb + (size_t)qrow0 * 1024 + h * 128 + mp * 64, kb + h * 128 + mp * 64, nullptr, vb + h * 128, lat_row, ctx_row, nt_lat, NT, o, l_reg, lds);
    __attribute__((address_space(1))) char* sq = (__attribute__((address_space(1))) char*)(stash + (size_t)(qrow0 + wid * 32 + hi * 4) * 1024 + h * 128 + r32);
    if (mp == 0) {
      #pragma unroll
      for (int r = 0; r < 16; ++r) { const float rl = __builtin_amdgcn_rcpf(o[4][r]);
        asm volatile("" : "+v"(sq));
        #pragma unroll
        for (int d0 = 0; d0 < 4; ++d0) ((__attribute__((address_space(1))) float*)sq)[d0 * 32] = o[d0][r] * rl;
        sq += ((r & 3) == 3 ? 5 : 1) * 4096; }
    } else {
      __attribute__((address_space(1))) char* oq = (__attribute__((address_space(1))) char*)(qb + (size_t)(qrow0 + wid * 32 + hi * 4) * 1024 + h * 128 + r32);
      float g4[4];
      #pragma unroll
      for (int d0 = 0; d0 < 4; ++d0) g4[d0] = subln[d0 * 32 + r32] * oscale;
      #pragma unroll
      for (int r = 0; r < 16; ++r) { const float rl = __builtin_amdgcn_rcpf(o[4][r]);
        asm volatile("" : "+v"(sq)); asm volatile("" : "+v"(oq));
        float d[4]; float ss = 0.f;
        #pragma unroll
        for (int d0 = 0; d0 < 4; ++d0) { d[d0] = ((const __attribute__((address_space(1))) float*)sq)[d0 * 32] - lam * (o[d0][r] * rl); ss += d[d0] * d[d0]; }
        ss = DPP_ADD(ss, 0xB1); ss = DPP_ADD(ss, 0x4E); ss = DPP_ADD(ss, 0x141); ss = DPP_ADD(ss, 0x140); ss += shx(ss, 16);
        const float rn = rsqrtf(ss * (1.f / 128.f) + EPS);
        if (!dry) { _Pragma("unroll") for (int d0 = 0; d0 < 4; ++d0) ((__attribute__((address_space(1))) u16*)oq)[d0 * 32] = f2bf(d[d0] * rn * g4[d0]); }
        sq += ((r & 3) == 3 ? 5 : 1) * 4096; oq += ((r & 3) == 3 ? 5 : 1) * 2048; }
    }
    __syncthreads();
  }
}
__device__ __forceinline__ void mla_unit(unsigned char* ws, int qrow0, int h, int lat_row, int ctx_row, int nt_lat, int NT, char* lds) {
  const int tid = otid(), wid = tid >> 6, lane = tid & 63, r32 = lane & 31, hi = lane >> 5;
  const bf16* qc = (const bf16*)(ws + WS_QC); const bf16* kvc = (const bf16*)(ws + WS_KVC); const bf16* kr = (const bf16*)(ws + WS_KR);
  bf16* oc = (bf16*)(ws + WS_OC);
  float* li_l = (float*)(lds + 2 * SHM_V + 2 * SHM_K) + wid * 64;
  f32x16 o[3]; float l_reg;
  attn_body<1>(qc + (size_t)qrow0 * 1536 + h * 96, kvc + h * 128, kr, kvc + h * 128 + 64, lat_row, ctx_row, nt_lat, NT, o, l_reg, lds);
  __attribute__((address_space(1))) char* oq = (__attribute__((address_space(1))) char*)(oc + (size_t)(qrow0 + wid * 32 + hi * 4) * 1024 + h * 64 + r32);
  #pragma unroll
  for (int r = 0; r < 16; ++r) { const float rl = __builtin_amdgcn_rcpf(o[2][r]);
    asm volatile("" : "+v"(oq));
    #pragma unroll
    for (int d0 = 0; d0 < 2; ++d0) ((__attribute__((address_space(1))) u16*)oq)[d0 * 32] = f2bf(o[d0][r] * rl);
    oq += ((r & 3) == 3 ? 5 : 1) * 2048; }
  __syncthreads();
}

__device__ __forceinline__ void sg_unit(unsigned char* ws, bf16* oa_base, int chunk, int g, const float* lng, const float* lnb, const float* spw, const float* spb, char* lds) {
  const int tid = otid(), wid = tid >> 6, lane = tid & 63, fr = lane & 15, fq = lane >> 4;
  bf16* ga = (bf16*)(ws + WS_GA) + (size_t)chunk * 128 * 2048;
  constexpr int LDT = 136;
  u16* wS = (u16*)lds;
  u16* vT = (u16*)(lds + 128 * LDT * 2);
  float* mu = (float*)(lds + 2 * 128 * LDT * 2); float* rs = mu + 128;
  #pragma unroll 1
  for (int i0 = 0; i0 < 16; i0 += 4) {
    bf16x8 a[4], b[4];
    #pragma unroll
    for (int q = 0; q < 4; ++q) { const bf16* vp = ga + (size_t)(wid * 16 + i0 + q) * 2048 + 1024 + lane * 16;
      a[q] = *reinterpret_cast<const bf16x8*>(vp); b[q] = *reinterpret_cast<const bf16x8*>(vp + 8); }
    #pragma unroll
    for (int q = 0; q < 4; ++q) {
      float x[16];
      #pragma unroll
      for (int k = 0; k < 8; ++k) { x[k] = bf2f((u16)a[q][k]); x[8 + k] = bf2f((u16)b[q][k]); }
      float s = 0.f;
      #pragma unroll
      for (int k = 0; k < 16; ++k) s += x[k];
      s = wave_sum(s);
      const float mean = s * (1.f / 1024.f);
      float qq = 0.f;
      #pragma unroll
      for (int k = 0; k < 16; ++k) { float d = x[k] - mean; qq += d * d; }
      qq = wave_sum(qq);
      if (lane == 0) { mu[wid * 16 + i0 + q] = mean; rs[wid * 16 + i0 + q] = rsqrtf(qq * (1.f / 1024.f) + EPS); }
    }
  }
  #pragma unroll
  for (int it = 0; it < 8; ++it) { const int idx = tid + it * NTHR;
    const int i = idx >> 5, j4 = (idx & 31) * 4;
    f32x4 w = *reinterpret_cast<const f32x4*>(spw + (size_t)g * 16384 + i * 128 + j4);
    u32x2 pk = {cvtpk(w[0], w[1]), cvtpk(w[2], w[3])};
    *reinterpret_cast<u32x2*>(wS + i * LDT + j4) = pk;
  }
  __syncthreads();
  #pragma unroll
  for (int it = 0; it < 4; ++it) { const int idx = tid + it * NTHR;
    const int j = idx & 127, c8 = (idx >> 7) * 8;
    bf16x8 v = *reinterpret_cast<const bf16x8*>(ga + (size_t)j * 2048 + 1024 + g * 128 + c8);
    const float m_ = mu[j], r_ = rs[j];
    #pragma unroll
    for (int k = 0; k < 8; ++k) { const int c = c8 + k;
      float y = (bf2f((u16)v[k]) - m_) * r_ * lng[g * 128 + c] + lnb[g * 128 + c];
      vT[c * LDT + j] = f2bf(y); }
  }
  __syncthreads();
  bf16x8 af[4];
  #pragma unroll
  for (int k = 0; k < 4; ++k) af[k] = *reinterpret_cast<const bf16x8*>(wS + (wid * 16 + fr) * LDT + k * 32 + fq * 8);
  u16 uv[8][4];
  #pragma unroll
  for (int cb = 0; cb < 8; ++cb)
  #pragma unroll
  for (int j = 0; j < 4; ++j) uv[cb][j] = *reinterpret_cast<const u16*>(ga + (size_t)(wid * 16 + fq * 4 + j) * 2048 + g * 128 + cb * 16 + fr);
  #pragma unroll
  for (int cb = 0; cb < 8; ++cb) {
    f32x4 acc = {0.f, 0.f, 0.f, 0.f};
    #pragma unroll
    for (int k = 0; k < 4; ++k) {
      bf16x8 bfr = *reinterpret_cast<const bf16x8*>(vT + (cb * 16 + fr) * LDT + k * 32 + fq * 8);
      acc = __builtin_amdgcn_mfma_f32_16x16x32_bf16(af[k], bfr, acc, 0, 0, 0);
    }
    #pragma unroll
    for (int j = 0; j < 4; ++j) {
      const int i = wid * 16 + fq * 4 + j;
      const float z = acc[j] + spb[g * 128 + i];
      *reinterpret_cast<u16*>(oa_base + ((size_t)chunk * 128 + i) * 1024 + g * 128 + cb * 16 + fr) = f2bf(bf2f(uv[cb][j]) * z);
    }
  }
  __syncthreads();
}

__device__ __forceinline__ int perm_col(int ptype, int n) {
  if (ptype == 1) { int t = n / DFF, c = n - t * DFF; return 256 * (c >> 7) + 128 * t + (c & 127); }
  if (ptype == 2 && n >= 2048 && n < 4096) { int d = n & 63; int s = d >> 5, c = (d >> 4) & 1, i = d & 15; return (n & ~63) + c * 32 + s * 16 + i; }
  return n;
}
__device__ __forceinline__ void tconv_tile(const float* __restrict__ src, int N, int k0, int n0, bf16* __restrict__ dst, int K, int ptype, const float* kscale, float* tl) {
  const int tid = otid();
  #pragma unroll
  for (int i = 0; i < 2; ++i) {
    const int idx = tid + i * NTHR, kk = idx >> 4, c4 = (idx & 15) * 4;
    float zz = 0.f; asm volatile("" : "+v"(zz));
    f32x4 v = {zz, zz, zz, zz};
    if (n0 + c4 < N) v = *reinterpret_cast<const f32x4*>(src + (size_t)(k0 + kk) * N + n0 + c4);
    if (kscale) { const float s = kscale[k0 + kk]; v[0] *= s; v[1] *= s; v[2] *= s; v[3] *= s; }
    tl[kk * 65 + c4 + 0] = v[0]; tl[kk * 65 + c4 + 1] = v[1]; tl[kk * 65 + c4 + 2] = v[2]; tl[kk * 65 + c4 + 3] = v[3];
  }
  __syncthreads();
  { const int nn = tid >> 3, kg = (tid & 7) * 8;
    if (n0 + nn < N) {
      u32x4 w;
      w[0] = cvtpk(tl[(kg + 0) * 65 + nn], tl[(kg + 1) * 65 + nn]); w[1] = cvtpk(tl[(kg + 2) * 65 + nn], tl[(kg + 3) * 65 + nn]);
      w[2] = cvtpk(tl[(kg + 4) * 65 + nn], tl[(kg + 5) * 65 + nn]); w[3] = cvtpk(tl[(kg + 6) * 65 + nn], tl[(kg + 7) * 65 + nn]);
      *reinterpret_cast<u32x4*>(dst + (size_t)perm_col(ptype, n0 + nn) * K + k0 + kg) = w;
    } }
  __syncthreads();
}
struct ConvJob { const float* src; bf16* dst; const float* kscale; int K, N, ptype; };
__device__ __forceinline__ ConvJob conv_job(const Params& p, int l, int j) {
  ConvJob c; c.kscale = nullptr; c.ptype = 0;
  unsigned char* wl = p.ws + WS_W + (size_t)l * W_LAYER;
  switch (j) {
    case 0: c.src = p.in[I_F1W13] + (size_t)l * 1024 * 5632; c.dst = (bf16*)(wl + WO_W13A); c.K = 1024; c.N = 5632; c.ptype = 1; break;
    case 1: c.src = p.in[I_F1W2] + (size_t)l * 2816 * 1024; c.dst = (bf16*)(wl + WO_W2A); c.K = 2816; c.N = 1024; break;
    case 2: c.src = p.in[I_F2W13] + (size_t)l * 1024 * 5632; c.dst = (bf16*)(wl + WO_W13B); c.K = 1024; c.N = 5632; c.ptype = 1; break;
    case 3: c.src = p.in[I_F2W2] + (size_t)l * 2816 * 1024; c.dst = (bf16*)(wl + WO_W2B); c.K = 2816; c.N = 1024; break;
    case 4: c.src = p.in[I_WIN] + (size_t)l * 1024 * NWIN; c.dst = (bf16*)(wl + WO_WIN); c.K = 1024; c.N = NWIN; c.ptype = 2; break;
    case 5: c.src = p.in[I_WUQ] + (size_t)l * 512 * 1536; c.dst = (bf16*)(wl + WO_WUQ); c.K = 512; c.N = 1536; c.kscale = p.in[I_QNG] + l * 512; break;
    case 6: c.src = p.in[I_WUKV] + (size_t)l * 256 * 2048; c.dst = (bf16*)(wl + WO_WUKV); c.K = 256; c.N = 2048; c.kscale = p.in[I_KVNG] + l * 256; break;
    case 7: case 8: case 9: c.src = p.in[I_WBR] + ((size_t)l * 3 + (j - 7)) * 1024 * 1024; c.dst = (bf16*)(wl + WO_WBR) + (size_t)(j - 7) * 1024 * 1024; c.K = 1024; c.N = 1024; break;
    default: c.src = p.in[I_WOUT] + (size_t)l * 1024 * 1024; c.dst = (bf16*)(wl + WO_WOUT); c.K = 1024; c.N = 1024; break;
  }
  return c;
}

__device__ __forceinline__ void conv_layer(const Params& p, int l, int part, int nparts, int worker, int nworkers, char* lds, int j0 = 0, int j1 = 11) {
  float* tl = (float*)lds; int base = 0;
  const int s = nparts * nworkers, r = part + nparts * worker;
  for (int j = j0; j < j1; ++j) {
    ConvJob c = conv_job(p, l, j);
    const int nk = c.K / 64, nn = (c.N + 63) / 64, ntile = nk * nn;
    for (int t = (((r - base) % s) + s) % s; t < ntile; t += s) { const int tn = t / nk, tk = t - tn * nk; tconv_tile(c.src, c.N, tk * 64, tn * 64, c.dst, c.K, c.ptype, c.kscale, tl); }
    base += ntile;
  }
}
__device__ __forceinline__ void phase_prep(const Params& p, char* lds) {
  const int tid = otid(), G = ogx(), bx = obx();
  const long gtid = (long)bx * NTHR + tid, gsz = (long)G * NTHR;
  { float* cosb = (float*)(p.ws + WS_COSB); float* sinb = (float*)(p.ws + WS_SINB);
    for (long i = gtid; i < 4096 * 32; i += gsz) { int t = (int)(i >> 5), f = (int)(i & 31);
      float fr = powf(10000.f, -(float)(f & 15) / 16.f); float ang = (float)(f < 16 ? (t >> 6) : (t & 63)) * fr;
      cosb[i] = cosf(ang); sinb[i] = sinf(ang); }
    float* cosc = (float*)(p.ws + WS_COSC); float* sinc = (float*)(p.ws + WS_SINC);
    for (long i = gtid; i < 4096 * 16; i += gsz) { int t = (int)(i >> 4), f = (int)(i & 15);
      float fr = powf(10000.f, -(float)(f & 7) / 8.f); float ang = (float)(f < 8 ? (t >> 6) : (t & 63)) * fr;
      cosc[i] = cosf(ang); sinc[i] = sinf(ang); } }
  if (bx == 0 && tid < 128) {
    const int l = tid >> 6, k = tid & 63;
    float a = p.in[I_LQ1][l * 64 + k] * p.in[I_LK1][l * 64 + k], b = p.in[I_LQ2][l * 64 + k] * p.in[I_LK2][l * 64 + k];
    #pragma unroll
    for (int o = 1; o < 64; o <<= 1) { a += shx(a, o); b += shx(b, o); }
    if (k == 0) { const float lam_init = 0.8f - 0.6f * expf(-0.3f * (float)l); ((float*)(p.ws + WS_LAM))[l] = expf(a) - expf(b) + lam_init; }
  }
  for (int l = 0; l < 2; ++l) { u32x4* z = (u32x4*)(p.ws + WS_W + (size_t)l * W_LAYER + WO_WIN + (size_t)NWIN * 1024 * 2);
    unsigned z0 = 0; asm volatile("" : "+v"(z0));
    for (long i = gtid; i < (long)(NWINP - NWIN) * 1024 * 2 / 16; i += gsz) z[i] = u32x4{z0, z0, z0, z0}; }
  { float* sl = (float*)lds;
    float* red = sl + 9 * 1024;
    float* mod = (float*)(p.ws + WS_MOD);
    if (bx < 2 * 144) {
      for (int i = tid; i < 9 * 1024; i += NTHR) sl[i] = siluf_(i < 8192 ? p.in[I_C][i] : p.in[I_CCTX][i - 8192]);
      __syncthreads();
    }
    const int col = tid & 63, kg = tid >> 6;
    for (int it = bx; it < 2 * 144; it += G) {
      const int l = it / 144, n0 = (it % 144) * 64;
      const float* W = p.in[I_ADAW] + (size_t)l * 1024 * 9216 + n0 + col;
      float acc[9];
      #pragma unroll
      for (int j = 0; j < 9; ++j) acc[j] = 0.f;
      for (int k = kg * 128; k < kg * 128 + 128; ++k) {
        const float w = W[(size_t)k * 9216];
        #pragma unroll
        for (int j = 0; j < 9; ++j) acc[j] += sl[j * 1024 + k] * w;
      }
      #pragma unroll
      for (int j = 0; j < 9; ++j) red[(kg * 9 + j) * 64 + col] = acc[j];
      __syncthreads();
      for (int o = tid; o < 9 * 64; o += NTHR) { const int j = o >> 6, c = o & 63; float sm = 0.f;
        #pragma unroll
        for (int q = 0; q < 8; ++q) sm += red[(q * 9 + j) * 64 + c];
        mod[((size_t)l * 9 + j) * 9216 + n0 + c] = sm + p.in[I_ADAB][l * 9216 + n0 + c]; }
      __syncthreads();
    } }
  if (G == 256) conv_layer(p, 0, 0, 1, bx, G, lds, 0, 2);
  else { conv_layer(p, 0, 0, 1, bx, G, lds); conv_layer(p, 1, 0, 1, bx, G, lds); }
}

__device__ __forceinline__ void phase_norm(const Params& p, int l, int which) {
  const int tid_ = otid(); const int wid = tid_ >> 6, lane = tid_ & 63;
  const float* gain = p.in[which == 0 ? I_NFFN1 : (which == 1 ? I_NMIX : I_NFFN2)] + l * 1024;
  const float* mod = (const float*)(p.ws + WS_MOD) + (size_t)l * 9 * 9216;
  bf16* h = (bf16*)(p.ws + WS_H);
  for (int r0 = (obx() * 8 + wid) * 2; r0 < R_ALL; r0 += ogx() * 16) {
    const int rb = r0 & ~127;
    TileInfo ti = (l == 0 && which == 0) ? tile_info(rb, const_cast<float*>(p.in[I_X]), const_cast<float*>(p.in[I_CTX])) : tile_info(rb, p.out, (float*)(p.ws + WS_CTXRES));
    const float* x = ti.resid + (size_t)(r0 - rb) * DM;
    const float* sh = mod + (size_t)ti.mi * 9216 + (which * 3) * 1024; const float* sc = sh + 1024;
    f32x4 v[2][4]; float ss[2] = {0.f, 0.f};
    #pragma unroll
    for (int q = 0; q < 2; ++q)
    #pragma unroll
    for (int i = 0; i < 4; ++i) v[q][i] = *(const __attribute__((address_space(1))) f32x4*)(x + q * DM + i * 256 + lane * 4);
    #pragma unroll
    for (int q = 0; q < 2; ++q)
    #pragma unroll
    for (int i = 0; i < 4; ++i) ss[q] += v[q][i][0] * v[q][i][0] + v[q][i][1] * v[q][i][1] + v[q][i][2] * v[q][i][2] + v[q][i][3] * v[q][i][3];
    ss[0] = wave_sum(ss[0]); ss[1] = wave_sum(ss[1]);
    #pragma unroll
    for (int i = 0; i < 4; ++i) { const int c = i * 256 + lane * 4;
      f32x4 g = *reinterpret_cast<const f32x4*>(gain + c), s1 = *reinterpret_cast<const f32x4*>(sc + c), s0 = *reinterpret_cast<const f32x4*>(sh + c);
      #pragma unroll
      for (int q = 0; q < 2; ++q) { const float rn = rsqrtf(ss[q] * (1.f / 1024.f) + EPS); f32x4 y;
        #pragma unroll
        for (int j = 0; j < 4; ++j) y[j] = v[q][i][j] * rn * g[j] * (1.f + s1[j]) + s0[j];
        st4bf(h + (size_t)(r0 + q) * 1024 + c, y); } }
  }
}
__device__ __forceinline__ void phase_final(const Params& p) {
  const int tid_ = otid(); const int wid = tid_ >> 6, lane = tid_ & 63;
  const float* gain = p.in[I_NFINAL];
  for (int r = obx() * 8 + wid; r < NB * SEQ; r += ogx() * 8) {
    float* x = p.out + (size_t)r * DM;
    f32x4 v[4]; float ss = 0.f;
    #pragma unroll
    for (int i = 0; i < 4; ++i) { v[i] = *reinterpret_cast<const f32x4*>(x + i * 256 + lane * 4);
      ss += v[i][0] * v[i][0] + v[i][1] * v[i][1] + v[i][2] * v[i][2] + v[i][3] * v[i][3]; }
    ss = wave_sum(ss);
    const float rn = rsqrtf(ss * (1.f / 1024.f) + EPS);
    #pragma unroll
    for (int i = 0; i < 4; ++i) { const int c = i * 256 + lane * 4;
      f32x4 g = *reinterpret_cast<const f32x4*>(gain + c), y;
      #pragma unroll
      for (int j = 0; j < 4; ++j) y[j] = v[i][j] * rn * g[j];
      *reinterpret_cast<f32x4*>(x + c) = y; }
  }
}

__device__ __forceinline__ void phase_ffn_up(const Params& p, int l, int which, char* lds) {
  GridSched S{(const char*)(p.ws + WS_H), (const char*)(p.ws + WS_W + (size_t)l * W_LAYER + (which ? WO_W13B : WO_W13A)), (l == 1 && which == 1) ? 128 : R_ALL / 256, 5632 / 256, ogx(), obx(), (size_t)256 * 1024 * 2, 1, (l == 1 && which == 1)};
  EpiSwiglu E{(bf16*)(p.ws + WS_ACT)};
  gemm_phase((LAS unsigned char*)lds, 1024, S, E);
}
__device__ __forceinline__ void phase_ffn_down(const Params& p, int l, int which, char* lds) {
  GridSched S{(const char*)(p.ws + WS_ACT), (const char*)(p.ws + WS_W + (size_t)l * W_LAYER + (which ? WO_W2B : WO_W2A)), (l == 1 && which == 1) ? 128 : R_ALL / 256, 4, ogx(), obx(), (size_t)256 * DFF * 2, 1, (l == 1 && which == 1)};
  EpiResid E{p.out, (float*)(p.ws + WS_CTXRES), (const float*)(p.ws + WS_MOD) + (size_t)l * 9 * 9216 + (which ? 8 : 2) * 1024, 0.5f, 0, 0, (l == 0 && which == 0) ? p.in[I_X] : p.out, (l == 0 && which == 0) ? p.in[I_CTX] : (const float*)(p.ws + WS_CTXRES)};
#ifdef REP_RESID
  { EpiResid E2 = E; E2.dry = 1; gemm_phase((LAS unsigned char*)lds, DFF, S, E2); }
#endif
  gemm_phase((LAS unsigned char*)lds, DFF, S, E);
  { const int G = ogx(), bx = obx(); if (l == 0 && which == 0 && G == 256 && bx >= 32) conv_layer(p, 0, 0, 1, bx - 32, G - 32, lds, 2, 11); }
}
__device__ __forceinline__ void phase_win(const Params& p, int l, int g, char* lds) {
  GridSched S{(const char*)(p.ws + WS_H + (size_t)g * GR * 1024 * 2), (const char*)(p.ws + WS_W + (size_t)l * W_LAYER + WO_WIN), GR / 256, NWINP / 256, ogx(), obx(), (size_t)256 * 1024 * 2, 1, 0};
  EpiWin E{p.ws, p.in[I_BGATE] + l * 3072, g * GR};
  gemm_phase((LAS unsigned char*)lds, 1024, S, E);
}
__device__ __forceinline__ void phase_up(const Params& p, int l, int g, char* lds) {
  const int G = ogx(), bx = obx();
  { GridSched S{(const char*)(p.ws + WS_CQ), (const char*)(p.ws + WS_W + (size_t)l * W_LAYER + WO_WUQ), GR / 256, 6, G, bx, (size_t)256 * 512 * 2, 0, 0};
    EpiUp<1> E{p.ws, g * GR}; gemm_phase((LAS unsigned char*)lds, 512, S, E); }
  { GridSched S{(const char*)(p.ws + WS_CKV), (const char*)(p.ws + WS_W + (size_t)l * W_LAYER + WO_WUKV), GR / 256, 8, G, (bx + G - (204 % G)) % G, (size_t)256 * 256 * 2, 0, 0};
    EpiUp<0> E{p.ws, g * GR}; gemm_phase((LAS unsigned char*)lds, 256, S, E); }
}
__device__ __forceinline__ void phase_merge(const Params& p, int l, int g, char* lds) {
  MergeSched S{(const char*)(p.ws + WS_H + (size_t)g * GR * 1024 * 2), (const char*)(p.ws + WS_QB), (const char*)(p.ws + WS_OC),
               (const char*)(p.ws + WS_W + (size_t)l * W_LAYER + WO_WBR), GR / 256, 4, ogx(), obx()};
  EpiMerge E{p.ws};
  gemm_phase((LAS unsigned char*)lds, 1024, S, E);
  { const int G = ogx(), bx = obx(); if (l == 0 && G == 256 && bx >= 136) conv_layer(p, 1, g, 4, bx - 136, G - 136, lds); }
}
__device__ __forceinline__ void phase_wout(const Params& p, int l, int g, char* lds) {
  const int G = ogx();
  GridSched S{(const char*)(p.ws + WS_Y), (const char*)(p.ws + WS_W + (size_t)l * W_LAYER + WO_WOUT), GR / 256, 4, G, (obx() + G - (120 % G)) % G, (size_t)256 * 1024 * 2, 2, 0};
  EpiResid E{p.out, (float*)(p.ws + WS_CTXRES), (const float*)(p.ws + WS_MOD) + (size_t)l * 9 * 9216 + 5 * 1024, 1.0f, g * GR, 0, p.out, (const float*)(p.ws + WS_CTXRES)};
#ifdef REP_RESID
  { EpiResid E2 = E; E2.dry = 1; gemm_phase((LAS unsigned char*)lds, 1024, S, E2); }
#endif
  gemm_phase((LAS unsigned char*)lds, 1024, S, E);
}

__device__ __forceinline__ void phase_mix(const Params& p, int l, int g, char* lds) {
  const float lam = ((const float*)(p.ws + WS_LAM))[l];
  const float lam_init = 0.8f - 0.6f * expf(-0.3f * (float)l);
  const float* subln = p.in[I_SUBLN] + l * 128;
  const int nctx = (l == 0) ? 48 : 0;
  const int nchunk = (l == 0 ? 68 : 64);
  const int nsg = ((nchunk + 7) / 8) * 64;
  const int total = 256 + 512 + nctx + nsg;
  for (int it = obx(); it < total; it += ogx()) {
#ifndef MIXM
#define MIXM 7
#endif
    if (it < 256) { if (!(MIXM & 1)) continue; const int pr = (it & 7) * 2 + (it >> 7), qb = (it >> 3) & 15; const int bb = pr >> 3, h = pr & 7;
#ifdef REP_DIFF
      diff_unit(p.ws, bb * 4096 + qb * 256, h, bb * 4096, GLAT + bb * 256, 64, 68, lam, 1.f - lam_init, subln, lds, true);
#endif
      diff_unit(p.ws, bb * 4096 + qb * 256, h, bb * 4096, GLAT + bb * 256, 64, 68, lam, 1.f - lam_init, subln, lds);
    } else if (it < 768) { if (!(MIXM & 2)) continue; const int i2 = it - 256; const int pr = (i2 >> 8) * 16 + (i2 & 7) * 2 + ((i2 >> 7) & 1), qb = (i2 >> 3) & 15; const int bb = pr >> 4, h = pr & 15;
      for (int rep = 0; rep < REP_MLA; ++rep) mla_unit(p.ws, bb * 4096 + qb * 256, h, bb * 4096, GLAT + bb * 256, 64, 68, lds);
    } else if (it < 768 + nctx) { const int i3 = it - 768;
      if (i3 < 16) { if (!(MIXM & 1)) continue; const int bb = i3 >> 3, h = i3 & 7; diff_unit(p.ws, GLAT + bb * 256, h, 0, GLAT + bb * 256, 0, 4, lam, 1.f - lam_init, subln, lds); }
      else { if (!(MIXM & 2)) continue; const int i4 = i3 - 16; const int bb = i4 >> 4, h = i4 & 15; mla_unit(p.ws, GLAT + bb * 256, h, 0, GLAT + bb * 256, 0, 4, lds); }
    } else { if (!(MIXM & 4)) continue; const int ch = it - 768 - nctx;
      const int sx = ch & 7, sk = ch >> 3, schunk = (sk >> 3) * 8 + sx; if (schunk >= nchunk) continue;
      sg_unit(p.ws, (bf16*)(p.ws + WS_H) + (size_t)g * GR * 1024, schunk, sk & 7, p.in[I_LNVG] + l * 1024, p.in[I_LNVB] + l * 1024, p.in[I_SPW] + (size_t)l * 8 * 16384, p.in[I_SPB] + l * 1024, lds);
    }
  }
}

#define XB_TMO      128
#define XB_XCNT(j)  (256  + 64 * (j))
#define XB_XSUB(j)  (1280 + 64 * (j))
#define XB_XGEN(j)  (2304 + 64 * (j))
#define XB_TOP      3328
#define XB_TOPGEN   3392
#define XCD_BAR_WORDS 3456
#define XB_SPIN_CAP (1u << 20)
__device__ __forceinline__ unsigned xb_ld(unsigned* p)              { return __hip_atomic_load(p, __ATOMIC_RELAXED, __HIP_MEMORY_SCOPE_AGENT); }
__device__ __forceinline__ unsigned xb_add(unsigned* p, unsigned v) { return __hip_atomic_fetch_add(p, v, __ATOMIC_RELAXED, __HIP_MEMORY_SCOPE_AGENT); }
__device__ __forceinline__ unsigned xb_xcc_id() { return (unsigned)__builtin_amdgcn_s_getreg((3 << 11) | 20) & 0xFu; }
#define XB_SPIN(cond, bar) do { unsigned _sp = 0; while (cond) { __builtin_amdgcn_s_sleep(1); \
    if ((++_sp & 255u) == 0u) { if (xb_ld(&(bar)[XB_TMO])) break; if (_sp > XB_SPIN_CAP) { atomicAdd(&(bar)[XB_TMO], 1u); break; } } } } while (0)
__device__ __forceinline__ void xcd_barrier_complete(unsigned* bar, unsigned x, unsigned& nloc, unsigned& nx) {
  const unsigned G = gridDim.x * gridDim.y * gridDim.z;
  unsigned sum, cnt, mine, sp = 0u;
  for (;;) {
    sum = 0u; cnt = 0u; mine = 0u;
    #pragma unroll
    for (unsigned j = 0; j < 16; ++j) { const unsigned c = xb_ld(&bar[XB_XCNT(j)]); sum += c; cnt += (c > 0u) ? 1u : 0u; mine = (j == x) ? c : mine; }
    if (sum == G) break;
    __builtin_amdgcn_s_sleep(1);
    if ((++sp & 255u) == 0u) { if (xb_ld(&bar[XB_TMO])) break; if (sp > XB_SPIN_CAP) { atomicAdd(&bar[XB_TMO], 1u); break; } }
  }
  nloc = mine > 0u ? mine : 1u; nx = cnt > 0u ? cnt : 1u;
}
__device__ __forceinline__ void xcd_barrier(unsigned* bar, volatile LAS unsigned* st) {
  asm volatile("s_waitcnt vmcnt(0) lgkmcnt(0)" ::: "memory");
  __syncthreads();
  if (threadIdx.x == 0) {
    const unsigned x = xb_xcc_id();
    unsigned nloc = st[0], nx = st[1];
    if (nloc == 0u) { xcd_barrier_complete(bar, x, nloc, nx); st[0] = nloc; st[1] = nx; }
    const unsigned old = xb_add(&bar[XB_XSUB(x)], 1u);
    const unsigned gen = old / nloc;
    if (old + 1u == (gen + 1u) * nloc) {
      __builtin_amdgcn_fence(__ATOMIC_RELEASE, "agent");
      asm volatile("s_waitcnt vmcnt(0)" ::: "memory");
      const unsigned og = xb_add(&bar[XB_TOP], 1u);
      const unsigned tg = og / nx;
      if (og + 1u == (tg + 1u) * nx) xb_add(&bar[XB_TOPGEN], 1u);
      else XB_SPIN(xb_ld(&bar[XB_TOPGEN]) == tg, bar);
      __builtin_amdgcn_fence(__ATOMIC_ACQUIRE, "agent");
      xb_add(&bar[XB_XGEN(x)], 1u);
      asm volatile("s_waitcnt vmcnt(0)" ::: "memory");
    } else {
      XB_SPIN(xb_ld(&bar[XB_XGEN(x)]) == gen, bar);
      __builtin_amdgcn_fence(__ATOMIC_ACQUIRE, "agent");
      asm volatile("s_waitcnt vmcnt(0)" ::: "memory");
    }
  }
  __syncthreads();
}

constexpr int N_PHASES = 50;
__device__ __forceinline__ void run_phase(const Params& p, int ph, char* lds) {
  if (ph == 0) { phase_prep(p, lds);
#ifdef REP_PREP
    phase_prep(p, lds);
#endif
    return; }
  if (ph == N_PHASES - 1) { phase_final(p); return; }
  const int l = (ph - 1) / 24, q = (ph - 1) % 24;
  if (q == 0) phase_norm(p, l, 0);
  else if (q == 1) { for (int rep = 0; rep < REP_GEMM; ++rep) phase_ffn_up(p, l, 0, lds); }
  else if (q == 2) phase_ffn_down(p, l, 0, lds);
  else if (q == 3) phase_norm(p, l, 1);
  else if (q < 21) { const int g = (q - 4) >> 2, s = (q - 4) & 3;
    if (s == 0) { if (g > 0) phase_wout(p, l, g - 1, lds);
      if (g < 4) { for (int rep = 0; rep < REP_GEMM; ++rep) phase_win(p, l, g, lds); } }
    else if (s == 1) { for (int rep = 0; rep < REP_GEMM; ++rep) phase_up(p, l, g, lds); }
    else if (s == 2) phase_mix(p, l, g, lds);
    else { for (int rep = 0; rep < REP_GEMM; ++rep) phase_merge(p, l, g, lds); }
  }
  else if (q == 21) phase_norm(p, l, 2);
  else if (q == 22) { for (int rep = 0; rep < REP_GEMM; ++rep) phase_ffn_up(p, l, 1, lds); }
  else phase_ffn_down(p, l, 1, lds);
}

__global__ void __launch_bounds__(NTHR, 2) mega(Params p) {
  extern __shared__ __attribute__((aligned(16))) char lds[];
#if MK_COOP
  cg::grid_group grid = cg::this_grid();
#endif
#if MK_COOP
  volatile LAS unsigned* xst = (volatile LAS unsigned*)((LAS unsigned char*)lds + LDS_SPARE);
  unsigned* xbar = (unsigned*)(p.ws + WS_XBAR);
  if (blockIdx.x == 0) for (int i = threadIdx.x; i < XCD_BAR_WORDS; i += NTHR) __hip_atomic_store(xbar + i, 0u, __ATOMIC_RELAXED, __HIP_MEMORY_SCOPE_AGENT);
  if (threadIdx.x < 2) xst[threadIdx.x] = 0u;
  grid.sync();
  if (threadIdx.x == 0) (void)xb_add(&xbar[XB_XCNT(xb_xcc_id())], 1u);
#endif
  for (int ph = p.ph_lo; ph < p.ph_hi; ++ph) {
    Params q = p;
    { __attribute__((address_space(1))) unsigned char* gws = (__attribute__((address_space(1))) unsigned char*)q.ws;
      __attribute__((address_space(1))) float* gout = (__attribute__((address_space(1))) float*)q.out;
      asm volatile("" : "+s"(gws), "+s"(gout));
      q.ws = (unsigned char*)gws; q.out = (float*)gout; }
    run_phase(q, ph, lds);
#if MK_COOP
    if (ph + 1 < p.ph_hi) xcd_barrier((unsigned*)(p.ws + WS_XBAR), (volatile LAS unsigned*)((LAS unsigned char*)lds + LDS_SPARE));
#endif
  }
}

extern "C" void kernel_launch(void* const* d_in, const int* in_sizes, int n_in, void* d_out, int out_size, void* d_ws, size_t ws_size, hipStream_t stream) {
  static int grid_blocks = 0;
  if (!grid_blocks) {
    int dev = 0, cus = 0, per_cu = 0;
    (void)hipGetDevice(&dev);
    (void)hipDeviceGetAttribute(&cus, hipDeviceAttributeMultiprocessorCount, dev);
    (void)hipFuncSetAttribute((const void*)mega, hipFuncAttributeMaxDynamicSharedMemorySize, LDS_BYTES);
    (void)hipOccupancyMaxActiveBlocksPerMultiprocessor(&per_cu, (const void*)mega, NTHR, LDS_BYTES);
    if (per_cu < 1) per_cu = 1;
    grid_blocks = cus * per_cu;
    if (ws_size < WS_END) fprintf(stderr, "kernel_launch: workspace too small: %zu < %zu\n", ws_size, (size_t)WS_END);
  }
  if (n_in < 31 || ws_size < WS_END) return;
  Params p{};
  for (int i = 0; i < 31; ++i) p.in[i] = (const float*)d_in[i];
  p.out = (float*)d_out; p.ws = (unsigned char*)d_ws;
#if MK_COOP
  (void)hipMemsetAsync((unsigned char*)d_ws + WS_BAR, 0, 256 + 16384, stream);
  p.ph_lo = 0; p.ph_hi = N_PHASES;
  void* args[] = {&p};
  hipError_t e = hipLaunchCooperativeKernel((void*)mega, dim3(grid_blocks), dim3(NTHR), args, LDS_BYTES, stream);
  if (e != hipSuccess) fprintf(stderr, "cooperative launch failed: %s (grid %d)\n", hipGetErrorString(e), grid_blocks);
#else
  for (int ph = 0; ph < N_PHASES; ++ph) { p.ph_lo = ph; p.ph_hi = ph + 1;
    hipLaunchKernelGGL(mega, dim3(grid_blocks), dim3(NTHR), LDS_BYTES, stream, p); }
#endif
}
```

```cpp
#include <hip/hip_runtime.h>
#include <hip/hip_bf16.h>
#include <hip/hip_cooperative_groups.h>
#include <cstdio>
#include <cstdint>
namespace cg = cooperative_groups;

#ifndef REP_GEMM
#define REP_GEMM 1
#endif
#ifndef REP_MLA
#define REP_MLA 1
#endif
#ifndef MK_COOP
#define MK_COOP 1
#endif

using bf16 = __hip_bfloat16;
typedef unsigned short u16;
using bf16x8 = __attribute__((ext_vector_type(8))) short;
using s16x4  = __attribute__((ext_vector_type(4))) short;
using f32x4  = __attribute__((ext_vector_type(4))) float;
using f32x16 = __attribute__((ext_vector_type(16))) float;
using u32x4  = __attribute__((ext_vector_type(4))) unsigned;
using u32x2  = __attribute__((ext_vector_type(2))) unsigned;

constexpr int DM = 1024, NB = 8, SEQ = 4096, CTXL = 256, DFF = 2816, NMOD = 9;
constexpr int R_ALL = 34816;
constexpr int GR = 8704, NGRP = 4, GLAT = 8192;
constexpr int NWIN = 8992, NWINP = 9216;
constexpr float EPS = 1e-6f;
constexpr int NTHR = 512;
constexpr int LDS_BYTES = 136 * 1024;
constexpr int LDS_SPARE = 128 * 1024;

enum { I_X = 0, I_C, I_CTX, I_CCTX, I_ADAW, I_ADAB, I_NFFN1, I_F1W13, I_F1W2, I_NMIX, I_WIN, I_BGATE, I_LNVG, I_LNVB, I_SPW, I_SPB,
       I_LQ1, I_LK1, I_LQ2, I_LK2, I_SUBLN, I_QNG, I_WUQ, I_KVNG, I_WUKV, I_WBR, I_WOUT, I_NFFN2, I_F2W13, I_F2W2, I_NFINAL };

constexpr size_t al256(size_t x) { return (x + 255) / 256 * 256; }
constexpr size_t WS_CTXRES = 0;
constexpr size_t WS_MOD   = WS_CTXRES + (size_t)2048 * 1024 * 4;
constexpr size_t WS_COSB  = WS_MOD + al256((size_t)2 * 9 * 9216 * 4);
constexpr size_t WS_SINB  = WS_COSB + (size_t)4096 * 32 * 4;
constexpr size_t WS_COSC  = WS_SINB + (size_t)4096 * 32 * 4;
constexpr size_t WS_SINC  = WS_COSC + (size_t)4096 * 16 * 4;
constexpr size_t WS_LAM   = WS_SINC + (size_t)4096 * 16 * 4;
constexpr size_t WS_BAR   = WS_LAM + 256;
constexpr size_t WS_XBAR  = WS_BAR + 256;
constexpr size_t WS_W     = WS_XBAR + 16384;
constexpr size_t WO_W13A = 0;
constexpr size_t WO_W2A  = WO_W13A + (size_t)5632 * 1024 * 2;
constexpr size_t WO_W13B = WO_W2A + (size_t)1024 * 2816 * 2;
constexpr size_t WO_W2B  = WO_W13B + (size_t)5632 * 1024 * 2;
constexpr size_t WO_WIN  = WO_W2B + (size_t)1024 * 2816 * 2;
constexpr size_t WO_WUQ  = WO_WIN + (size_t)NWINP * 1024 * 2;
constexpr size_t WO_WUKV = WO_WUQ + (size_t)1536 * 512 * 2;
constexpr size_t WO_WBR  = WO_WUKV + (size_t)2048 * 256 * 2;
constexpr size_t WO_WOUT = WO_WBR + (size_t)3 * 1024 * 1024 * 2;
constexpr size_t W_LAYER = WO_WOUT + (size_t)1024 * 1024 * 2;
constexpr size_t WS_H    = WS_W + 2 * W_LAYER;
constexpr size_t WS_BIG  = WS_H + (size_t)R_ALL * 1024 * 2;
constexpr size_t WS_ACT  = WS_BIG;
constexpr size_t WS_GA   = WS_BIG;
constexpr size_t WS_QB   = WS_GA + (size_t)GR * 2048 * 2;
constexpr size_t WS_KB   = WS_QB + (size_t)GR * 1024 * 2;
constexpr size_t WS_VB   = WS_KB + (size_t)GR * 1024 * 2;
constexpr size_t WS_CQ   = WS_VB + (size_t)GR * 1024 * 2;
constexpr size_t WS_CKV  = WS_CQ + (size_t)GR * 512 * 2;
constexpr size_t WS_KR   = WS_CKV + (size_t)GR * 256 * 2;
constexpr size_t WS_GATES= WS_KR + (size_t)GR * 32 * 2;
constexpr size_t WS_QC   = WS_GATES + (size_t)GR * 3072 * 2;
constexpr size_t WS_KVC  = WS_QC + (size_t)GR * 1536 * 2;
constexpr size_t WS_OC   = WS_KVC + (size_t)GR * 2048 * 2;
constexpr size_t WS_YTMP = WS_OC + (size_t)GR * 1024 * 2;
constexpr size_t WS_SSQ  = WS_YTMP + (size_t)GR * 1024 * 4;
constexpr size_t WS_SSKV = WS_SSQ + (size_t)GR * 16 * 4;
constexpr size_t WS_MIXEND = WS_SSKV + (size_t)GR * 8 * 4;
constexpr size_t WS_Y    = WS_KVC;
constexpr size_t WS_FFNEND = WS_ACT + (size_t)R_ALL * DFF * 2;
constexpr size_t WS_END  = WS_MIXEND > WS_FFNEND ? WS_MIXEND : WS_FFNEND;

struct Params { const float* in[31]; float* out; unsigned char* ws; int ph_lo, ph_hi; };

__device__ __forceinline__ unsigned cvtpk(float lo, float hi) {
  unsigned r; asm volatile("v_cvt_pk_bf16_f32 %0, %1, %2" : "=v"(r) : "v"(lo), "v"(hi)); return r;
}
__device__ __forceinline__ unsigned cvtpk_s(float lo, float hi) {
  unsigned r; asm volatile("s_nop 1\n\tv_cvt_pk_bf16_f32 %0, %1, %2" : "=v"(r) : "v"(lo), "v"(hi)); return r;
}
__device__ __forceinline__ u16 f2bf(float x) { return (u16)(cvtpk_s(x, 0.f) & 0xffffu); }
__device__ __forceinline__ float bf2f(u16 u) { return __uint_as_float(((unsigned)u) << 16); }
__device__ __forceinline__ float bflo(unsigned w) { return __uint_as_float(w << 16); }
__device__ __forceinline__ float bfhi(unsigned w) { return __uint_as_float(w & 0xffff0000u); }
__device__ __forceinline__ float sigmoidf_(float x) { return __builtin_amdgcn_rcpf(1.f + __expf(-x)); }
__device__ __forceinline__ float siluf_(float x) { return x * __builtin_amdgcn_rcpf(1.f + __expf(-x)); }
__device__ __forceinline__ float gelu_tanh(float x) {
  float u = 0.7978845608028654f * (x + 0.044715f * x * x * x);
  float t = 1.f - 2.f * __builtin_amdgcn_rcpf(1.f + __expf(2.f * u));
  return 0.5f * x * (1.f + t);
}

__device__ __forceinline__ int obx() { int t = __builtin_amdgcn_workgroup_id_x(); asm volatile("" : "+s"(t)); return t; }
__device__ __forceinline__ int ogx() { int t = __builtin_amdgcn_grid_size_x() / NTHR; asm volatile("" : "+s"(t)); return t; }
__device__ __forceinline__ int otid() { int t = threadIdx.x; asm volatile("" : "+v"(t)); return t; }
__device__ __forceinline__ float shx(float v, int m) { const int l = otid(); return __int_as_float(__builtin_amdgcn_ds_bpermute(((l ^ m) & 63) << 2, __float_as_int(v))); }
#define DPP_ADD(v, CTRL) ((v) + __int_as_float(__builtin_amdgcn_mov_dpp(__float_as_int(v), CTRL, 0xF, 0xF, true)))
__device__ __forceinline__ float wave_sum(float v) {
  v = DPP_ADD(v, 0xB1); v = DPP_ADD(v, 0x4E); v = DPP_ADD(v, 0x141); v = DPP_ADD(v, 0x140);
  v += shx(v, 16); v += shx(v, 32); return v;
}
struct TileInfo { float* resid; int mi; int t0; bool lat; };
__device__ __forceinline__ TileInfo tile_info(int r, float* out, float* ctxres) {
  TileInfo ti; int g = r / GR; int rr = r - g * GR;
  if (rr < GLAT) { ti.resid = out + (size_t)(g * GLAT + rr) * DM; ti.mi = g * 2 + (rr >> 12); ti.t0 = rr & 4095; ti.lat = true; }
  else { int cr = rr - GLAT; ti.resid = ctxres + (size_t)(g * 512 + cr) * DM; ti.mi = 8; ti.t0 = 0; ti.lat = false; }
  return ti;
}

constexpr int BM = 256, BK = 64, HALF = 128, NXCD = 8, WGM = 8, HT = HALF * BK;
__device__ __forceinline__ int lds_byte(int r, int c) {
  int st = (r >> 4) * 2 + (c >> 5), rr = r & 15, cc = c & 31, ob = rr * 64 + cc * 2;
  return st * 1024 + (ob ^ (((ob >> 9) & 1) << 5));
}
__device__ __forceinline__ void stage_rc(int b, int& R, int& C) {
  int st = b / 1024, sb = b % 1024, swz = sb ^ (((sb >> 9) & 1) << 5);
  R = (st >> 1) * 16 + swz / 64; C = (st & 1) * 32 + (swz % 64) / 2;
}
__device__ __forceinline__ void tile_of(int L, int nM, int nN, int& pm, int& pn) {
  int nwg = nM * nN, wgid = L;
  { int q = nwg / NXCD, r = nwg % NXCD, xcd = wgid % NXCD, off = wgid / NXCD; wgid = (xcd < r ? xcd * (q + 1) : r * (q + 1) + (xcd - r) * q) + off; }
  int nig = WGM * nN, gid = wgid / nig, fm = gid * WGM, gsz = min(nM - fm, WGM);
  pm = fm + ((wgid % nig) % gsz); pn = (wgid % nig) / gsz;
}

typedef f32x4 Acc[2][2][4][2];
#define LAS __attribute__((address_space(3)))
constexpr int HTB = HALF * BK * 2;
struct Unit { const char* A; const char* B; int pm, pn, tag; };

struct GridSched {
  const char* A; const char* B; int nM, nN, G, c; size_t tstep; int xcd; int latonly;
  __device__ __forceinline__ bool next(int i, Unit& u) const {
    const int L = i * G + c; if (L >= nM * nN) return false;
    int pm, pn; if (xcd == 1) tile_of(L, nM, nN, pm, pn); else if (xcd == 2) { const int x = L & 7, jj = L >> 3; pn = x & 3; pm = 2 * jj + (x >> 2); } else { pm = L % nM; pn = L / nM; }
    if (latonly) pm = (pm >> 5) * 34 + (pm & 31);
    u.pm = pm; u.pn = pn; u.tag = 0; u.A = A + (size_t)pm * tstep; u.B = B + (size_t)pn * tstep; return true;
  }
};
struct MergeSched {
  const char* A0; const char* A1; const char* A2; const char* B; int nM, nN, G, c;
  __device__ __forceinline__ bool next(int i, Unit& u) const {
    const int t = i / 3, br = i - t * 3; const int L = t * G + c; if (L >= nM * nN) return false;
    const int x = L & 7, jj = L >> 3; const int pn = x & 3, pm = 2 * jj + (x >> 2);
    const size_t tstep = (size_t)256 * 1024 * 2;
    u.pm = pm; u.pn = pn; u.tag = br; u.A = (br == 0 ? A0 : (br == 1 ? A1 : A2)) + (size_t)pm * tstep; u.B = B + (size_t)br * 1024 * 1024 * 2 + (size_t)pn * tstep; return true;
  }
};

template <class Epi, class Sched, bool CARRY = false>
__device__ __forceinline__ void gemm_phase(LAS unsigned char* lds, const int K, const Sched& S, const Epi& E) {
  const int tid = otid(), wid = __builtin_amdgcn_readfirstlane(tid >> 6), lane = tid & 63, wr = wid >> 2, wc = wid & 3, fr = lane & 15, fq = lane >> 4;
  const int nt = K / BK;
  unsigned voff[2];
  #pragma unroll
  for (int i = 0; i < 2; ++i) { int R, C; stage_rc(tid * 16 + i * 8192, R, C); voff[i] = (unsigned)(R * K + C) * 2u; }
  const size_t kstep = (size_t)(BK * 2);
  const size_t hstep = (size_t)HALF * K * 2;
  const unsigned ldsw = (unsigned)wid * 1024u;
  const int aoff = lds_byte(wr * 64 + fr, fq * 8), boff = lds_byte(wc * 32 + fr, fq * 8);
#define PG8_SA(b, h) (((b) * 2 + (h)) * HTB)
#define PG8_SB(b, h) ((4 + (b) * 2 + (h)) * HTB)
#define PG8_STAGE(bufoff, gbase) do { _Pragma("unroll") for (int _i = 0; _i < 2; ++_i) \
    __builtin_amdgcn_global_load_lds((const unsigned*)((const char*)(gbase) + voff[_i]), (LAS unsigned*)(lds + (bufoff) + ldsw + _i * 8192), 16, 0, 0); } while (0)
#define PG8_LDA(dst, b, h) do { _Pragma("unroll") for (int m = 0; m < 4; ++m) _Pragma("unroll") for (int k = 0; k < 2; ++k) dst[m][k] = *(const LAS bf16x8*)(lds + PG8_SA(b, h) + aoff + m * 2048 + k * 1024); } while (0)
#define PG8_LDB(dst, b, h) do { _Pragma("unroll") for (int n = 0; n < 2; ++n) _Pragma("unroll") for (int k = 0; k < 2; ++k) dst[n][k] = *(const LAS bf16x8*)(lds + PG8_SB(b, h) + boff + n * 2048 + k * 1024); } while (0)
#define PG8_MMA(ai, bj, At, Bt) do { __builtin_amdgcn_s_setprio(1); _Pragma("unroll") for (int m = 0; m < 4; ++m) _Pragma("unroll") for (int n = 0; n < 2; ++n) _Pragma("unroll") for (int k = 0; k < 2; ++k) \
    acc[ai][bj][m][n] = __builtin_amdgcn_mfma_f32_16x16x32_bf16(Bt[n][k], At[m][k], acc[ai][bj][m][n], 0, 0, 0); __builtin_amdgcn_s_setprio(0); } while (0)
#define PG8_WAIT_V(n) asm volatile("s_waitcnt vmcnt(" #n ")" ::: "memory")
#define PG8_WAIT_L(n) asm volatile("s_waitcnt lgkmcnt(" #n ")" ::: "memory")
#define PG8_BAR __builtin_amdgcn_s_barrier()
#define PG8_SCHED __builtin_amdgcn_sched_barrier(0)
  Unit cur, nxt; int ui = 0;
  if (!S.next(0, cur)) return;
  f32x4 acc[2][2][4][2];
  float zz = 0.f; asm volatile("" : "+v"(zz));
  #pragma unroll
  for (int a = 0; a < 2; ++a)
  #pragma unroll
  for (int b = 0; b < 2; ++b)
  #pragma unroll
  for (int m = 0; m < 4; ++m)
  #pragma unroll
  for (int n = 0; n < 2; ++n) acc[a][b][m][n] = (f32x4){zz, zz, zz, zz};
  bf16x8 At[4][2], B0[2][2], B1[2][2];
  const char* cA = cur.A; const char* cB = cur.B;
  __builtin_amdgcn_s_waitcnt(0x0F70);
  PG8_STAGE(PG8_SB(0, 0), cB); PG8_STAGE(PG8_SA(0, 0), cA); PG8_STAGE(PG8_SB(0, 1), cB + hstep); PG8_STAGE(PG8_SA(0, 1), cA + hstep);
  if (wr == 1) PG8_BAR;
  PG8_WAIT_V(4); PG8_BAR;
  PG8_STAGE(PG8_SB(1, 0), cB + kstep); PG8_STAGE(PG8_SA(1, 0), cA + kstep); PG8_STAGE(PG8_SB(1, 1), cB + hstep + kstep);
  PG8_WAIT_V(6); PG8_BAR;
  for (;;) {
    const bool has_next = S.next(ui + 1, nxt);
    const char* nA = has_next ? nxt.A : cA; const char* nB = has_next ? nxt.B : cB;
    for (int t = 0; t < nt; t += 2) {
      const bool last = (t == nt - 2);
      const char* a1 = cA + (size_t)(t + 1) * kstep;
      const char* a2 = last ? nA : cA + (size_t)(t + 2) * kstep; const char* b2 = last ? nB : cB + (size_t)(t + 2) * kstep;
      const char* a3 = a2 + kstep; const char* b3 = b2 + kstep;
      PG8_LDB(B0, 0, 0); PG8_SCHED; PG8_LDA(At, 0, 0); PG8_STAGE(PG8_SA(1, 1), a1 + hstep);
      PG8_WAIT_L(8); PG8_BAR; PG8_WAIT_L(0); PG8_MMA(0, 0, At, B0); PG8_BAR; PG8_SCHED;
      PG8_LDB(B1, 0, 1); PG8_STAGE(PG8_SB(0, 0), b2);
      PG8_BAR; PG8_WAIT_L(0); PG8_MMA(0, 1, At, B1); PG8_BAR;
      PG8_LDA(At, 0, 1); PG8_STAGE(PG8_SA(0, 0), a2);
      PG8_BAR; PG8_WAIT_L(0); PG8_MMA(1, 0, At, B0); PG8_BAR; PG8_SCHED;
      PG8_STAGE(PG8_SB(0, 1), b2 + hstep);
      PG8_WAIT_V(6); PG8_BAR; PG8_MMA(1, 1, At, B1); PG8_BAR;
      PG8_LDB(B0, 1, 0); PG8_SCHED; PG8_LDA(At, 1, 0); PG8_STAGE(PG8_SA(0, 1), a2 + hstep);
      PG8_WAIT_L(8); PG8_BAR; PG8_WAIT_L(0); PG8_MMA(0, 0, At, B0); PG8_BAR; PG8_SCHED;
      PG8_LDB(B1, 1, 1); PG8_STAGE(PG8_SB(1, 0), b3);
      PG8_BAR; PG8_WAIT_L(0); PG8_MMA(0, 1, At, B1); PG8_BAR;
      PG8_LDA(At, 1, 1); PG8_STAGE(PG8_SA(1, 0), a3);
      PG8_BAR; PG8_WAIT_L(0); PG8_MMA(1, 0, At, B0); PG8_BAR; PG8_SCHED;
      PG8_STAGE(PG8_SB(1, 1), b3 + hstep);
      PG8_WAIT_V(6); PG8_BAR; PG8_MMA(1, 1, At, B1); PG8_BAR;
    }
    { const int t2 = otid(), l2 = t2 & 63; E.apply(acc, cur, wr, wc, l2 & 15, l2 >> 4); }
    if (!has_next) break;
    __builtin_amdgcn_s_waitcnt(0x0F70);
    if (!(CARRY && cur.tag < 2)) {
      #pragma unroll
      for (int a = 0; a < 2; ++a)
      #pragma unroll
      for (int b = 0; b < 2; ++b)
      #pragma unroll
      for (int m = 0; m < 4; ++m)
      #pragma unroll
      for (int n = 0; n < 2; ++n) acc[a][b][m][n] = (f32x4){zz, zz, zz, zz};
    }
    cur = nxt; cA = nA; cB = nB; ++ui;
  }
  PG8_WAIT_V(0);
  if (wr == 0) PG8_BAR;
  PG8_BAR;
#undef PG8_SA
#undef PG8_SB
#undef PG8_STAGE
#undef PG8_LDA
#undef PG8_LDB
#undef PG8_MMA
#undef PG8_WAIT_V
#undef PG8_WAIT_L
#undef PG8_BAR
#undef PG8_SCHED
}

__device__ __forceinline__ void st4bf(bf16* p, f32x4 v) {
  u32x2 w = {cvtpk_s(v[0], v[1]), cvtpk_s(v[2], v[3])}; *reinterpret_cast<u32x2*>(p) = w;
}

struct EpiSwiglu {
  bf16* act;
  __device__ __forceinline__ void apply(Acc& acc, const Unit& u, int wr, int wc, int fr, int fq) const {
    const int brow = u.pm * 256, bcol = u.pn * 256;
    const int cb = (bcol >> 1) + wc * 32 + fq * 4;
    #pragma unroll
    for (int ai = 0; ai < 2; ++ai)
    #pragma unroll
    for (int m = 0; m < 4; ++m) {
      const size_t row = brow + ai * 128 + wr * 64 + m * 16 + fr;
      #pragma unroll
      for (int n = 0; n < 2; ++n) {
        f32x4 a = acc[ai][0][m][n], b = acc[ai][1][m][n], v;
        #pragma unroll
        for (int j = 0; j < 4; ++j) v[j] = siluf_(a[j]) * b[j];
        st4bf(act + row * DFF + cb + n * 16, v);
      }
    }
  }
};
struct EpiResid {
  float* out; float* ctxres; const float* gate; float coef; int row0; int dry; const float* src_lat; const float* src_ctx;
  __device__ __forceinline__ void apply(Acc& acc, const Unit& u, int wr, int wc, int fr, int fq) const {
    const int brow = u.pm * 256, bcol = u.pn * 256;
    TileInfo ti = tile_info(row0 + brow, out, ctxres);
    const float* srcb = tile_info(row0 + brow, const_cast<float*>(src_lat), const_cast<float*>(src_ctx)).resid;
    const float* g = gate + (size_t)ti.mi * 9216;
    #pragma unroll
    for (int bj = 0; bj < 2; ++bj)
    #pragma unroll
    for (int n = 0; n < 2; ++n) {
      const int col = bcol + bj * 128 + wc * 32 + n * 16 + fq * 4;
      f32x4 gv = *(const __attribute__((address_space(1))) f32x4*)(g + col);
      #pragma unroll
      for (int ai = 0; ai < 2; ++ai)
      #pragma unroll
      for (int m = 0; m < 4; ++m) {
        float* p = ti.resid + (size_t)(ai * 128 + wr * 64 + m * 16 + fr) * DM + col;
        f32x4 x = *(const __attribute__((address_space(1))) f32x4*)(srcb + (size_t)(ai * 128 + wr * 64 + m * 16 + fr) * DM + col);
        #pragma unroll
        for (int j = 0; j < 4; ++j) x[j] += coef * gv[j] * acc[ai][bj][m][n][j];
        if (!dry) *(__attribute__((address_space(1))) f32x4*)(p) = x;
      }
    }
  }
};
struct EpiWin {
  unsigned char* ws; const float* bgate; int row0;
  __device__ __forceinline__ void apply(Acc& acc, const Unit& u, int wr, int wc, int fr, int fq) const {
    const int brow = u.pm * 256, bcol = u.pn * 256;
    TileInfo ti = tile_info(row0 + brow, nullptr, nullptr);
    const float* cosb = (const float*)(ws + WS_COSB); const float* sinb = (const float*)(ws + WS_SINB);
    const float* cosc = (const float*)(ws + WS_COSC); const float* sinc = (const float*)(ws + WS_SINC);
    #pragma unroll
    for (int bj = 0; bj < 2; ++bj) {
      const int c0 = bcol + bj * 128 + wc * 32;
      if (c0 >= NWIN) continue;
      if (c0 < 2048) {
        bf16* ga = (bf16*)(ws + WS_GA);
        #pragma unroll
        for (int ai = 0; ai < 2; ++ai)
        #pragma unroll
        for (int m = 0; m < 4; ++m) {
          const size_t row = brow + ai * 128 + wr * 64 + m * 16 + fr;
          #pragma unroll
          for (int n = 0; n < 2; ++n) { f32x4 v;
            #pragma unroll
            for (int j = 0; j < 4; ++j) v[j] = gelu_tanh(acc[ai][bj][m][n][j]);
            st4bf(ga + row * 2048 + c0 + n * 16 + fq * 4, v); }
        }
      } else if (c0 < 4096) {
        bf16* dst = (bf16*)(ws + (c0 < 3072 ? WS_QB : WS_KB));
        const int cc = (c0 - (c0 < 3072 ? 2048 : 3072));
        const int f0 = ((c0 >> 5) & 1) * 16 + fq * 4;
        #pragma unroll
        for (int ai = 0; ai < 2; ++ai)
        #pragma unroll
        for (int m = 0; m < 4; ++m) {
          const int rl = ai * 128 + wr * 64 + m * 16 + fr;
          const size_t row = brow + rl;
          f32x4 x1 = acc[ai][bj][m][0], x2 = acc[ai][bj][m][1], y1, y2;
          if (ti.lat) {
            const int t = ti.t0 + rl;
            f32x4 cs = *reinterpret_cast<const f32x4*>(cosb + t * 32 + f0), sn = *reinterpret_cast<const f32x4*>(sinb + t * 32 + f0);
            #pragma unroll
            for (int j = 0; j < 4; ++j) { y1[j] = x1[j] * cs[j] - x2[j] * sn[j]; y2[j] = x2[j] * cs[j] + x1[j] * sn[j]; }
          } else { y1 = x1; y2 = x2; }
          st4bf(dst + row * 1024 + cc + fq * 4, y1); st4bf(dst + row * 1024 + cc + 16 + fq * 4, y2);
        }
      } else if (c0 < 5120) {
        bf16* dst = (bf16*)(ws + WS_VB);
        #pragma unroll
        for (int ai = 0; ai < 2; ++ai)
        #pragma unroll
        for (int m = 0; m < 4; ++m) {
          const size_t row = brow + ai * 128 + wr * 64 + m * 16 + fr;
          #pragma unroll
          for (int n = 0; n < 2; ++n) st4bf(dst + row * 1024 + (c0 - 4096) + n * 16 + fq * 4, acc[ai][bj][m][n]);
        }
      } else if (c0 < 5888) {
        const bool isq = c0 < 5632;
        bf16* dst = (bf16*)(ws + (isq ? WS_CQ : WS_CKV));
        float* ss = (float*)(ws + (isq ? WS_SSQ : WS_SSKV));
        const int cc = c0 - (isq ? 5120 : 5632), ld = isq ? 512 : 256, nch = isq ? 16 : 8;
        #pragma unroll
        for (int ai = 0; ai < 2; ++ai)
        #pragma unroll
        for (int m = 0; m < 4; ++m) {
          const size_t row = brow + ai * 128 + wr * 64 + m * 16 + fr;
          float s = 0.f;
          #pragma unroll
          for (int n = 0; n < 2; ++n) {
            f32x4 v = acc[ai][bj][m][n];
            #pragma unroll
            for (int j = 0; j < 4; ++j) s += v[j] * v[j];
            st4bf(dst + row * ld + cc + n * 16 + fq * 4, v);
          }
          s += shx(s, 16); s += shx(s, 32);
          if (fq == 0) ss[row * nch + (cc >> 5)] = s;
        }
      } else if (c0 < 5920) {
        bf16* dst = (bf16*)(ws + WS_KR);
        #pragma unroll
        for (int ai = 0; ai < 2; ++ai)
        #pragma unroll
        for (int m = 0; m < 4; ++m) {
          const int rl = ai * 128 + wr * 64 + m * 16 + fr;
          const size_t row = brow + rl;
          f32x4 x1 = acc[ai][bj][m][0], x2 = acc[ai][bj][m][1], y1, y2;
          if (ti.lat) {
            const int t = ti.t0 + rl;
            f32x4 cs = *reinterpret_cast<const f32x4*>(cosc + t * 16 + fq * 4), sn = *reinterpret_cast<const f32x4*>(sinc + t * 16 + fq * 4);
            #pragma unroll
            for (int j = 0; j < 4; ++j) { y1[j] = x1[j] * cs[j] - x2[j] * sn[j]; y2[j] = x2[j] * cs[j] + x1[j] * sn[j]; }
          } else { y1 = x1; y2 = x2; }
          st4bf(dst + row * 32 + fq * 4, y1); st4bf(dst + row * 32 + 16 + fq * 4, y2);
        }
      } else {
        bf16* dst = (bf16*)(ws + WS_GATES);
        const int cc = c0 - 5920;
        #pragma unroll
        for (int n = 0; n < 2; ++n) {
          f32x4 bg = *reinterpret_cast<const f32x4*>(bgate + cc + n * 16 + fq * 4);
          #pragma unroll
          for (int ai = 0; ai < 2; ++ai)
          #pragma unroll
          for (int m = 0; m < 4; ++m) {
            const size_t row = brow + ai * 128 + wr * 64 + m * 16 + fr; f32x4 v;
            #pragma unroll
            for (int j = 0; j < 4; ++j) v[j] = sigmoidf_(acc[ai][bj][m][n][j] + bg[j]);
            st4bf(dst + row * 3072 + cc + n * 16 + fq * 4, v);
          }
        }
      }
    }
  }
};
template <int isq> struct EpiUp {
  unsigned char* ws; int row0;
  __device__ __forceinline__ void apply(Acc& acc, const Unit& u, int wr, int wc, int fr, int fq) const {
    const int brow = u.pm * 256, bcol = u.pn * 256;
    TileInfo ti = tile_info(row0 + brow, nullptr, nullptr);
    const float* cosc = (const float*)(ws + WS_COSC); const float* sinc = (const float*)(ws + WS_SINC);
    bf16* dst = (bf16*)(ws + (isq ? WS_QC : WS_KVC)); const int ld = isq ? 1536 : 2048;
    float rinv[2][4];
    { f32x4 pv[2][4];
      #pragma unroll
      for (int ai = 0; ai < 2; ++ai)
      #pragma unroll
      for (int m = 0; m < 4; ++m) {
        const size_t row = brow + ai * 128 + wr * 64 + m * 16 + fr;
        if (isq) pv[ai][m] = reinterpret_cast<const f32x4*>((const float*)(ws + WS_SSQ) + row * 16)[fq];
        else pv[ai][m] = reinterpret_cast<const f32x4*>((const float*)(ws + WS_SSKV) + row * 8)[fq & 1];
      }
      #pragma unroll
      for (int ai = 0; ai < 2; ++ai)
      #pragma unroll
      for (int m = 0; m < 4; ++m) {
        float sm = pv[ai][m][0] + pv[ai][m][1] + pv[ai][m][2] + pv[ai][m][3];
        if (!isq && fq >= 2) sm = 0.f;
        sm += shx(sm, 16); sm += shx(sm, 32);
        rinv[ai][m] = rsqrtf(sm * (isq ? 1.f / 512.f : 1.f / 256.f) + EPS);
      } }
    #pragma unroll
    for (int ai = 0; ai < 2; ++ai)
    #pragma unroll
    for (int m = 0; m < 4; ++m) {
      const int rl = ai * 128 + wr * 64 + m * 16 + fr;
      const size_t row = brow + rl; const float ri = rinv[ai][m];
      #pragma unroll
      for (int bj = 0; bj < 2; ++bj) {
        const int c0 = bcol + bj * 128 + wc * 32;
        const bool rope = isq && ((c0 >> 5) % 3 == 2) && ti.lat;
        f32x4 x1 = acc[ai][bj][m][0], x2 = acc[ai][bj][m][1], y1, y2;
        #pragma unroll
        for (int j = 0; j < 4; ++j) { x1[j] *= ri; x2[j] *= ri; }
        if (rope) {
          const int t = ti.t0 + rl;
          f32x4 cs = *reinterpret_cast<const f32x4*>(cosc + t * 16 + fq * 4), sn = *reinterpret_cast<const f32x4*>(sinc + t * 16 + fq * 4);
          #pragma unroll
          for (int j = 0; j < 4; ++j) { y1[j] = x1[j] * cs[j] - x2[j] * sn[j]; y2[j] = x2[j] * cs[j] + x1[j] * sn[j]; }
        } else { y1 = x1; y2 = x2; }
        st4bf(dst + row * ld + c0 + fq * 4, y1); st4bf(dst + row * ld + c0 + 16 + fq * 4, y2);
      }
    }
  }
};
struct EpiMerge {
  unsigned char* ws;
  __device__ __forceinline__ void apply(Acc& acc, const Unit& u, int wr, int wc, int fr, int fq) const {
    const int brow = u.pm * 256, bcol = u.pn * 256;
    const int br = u.tag;
    const bf16* gates = (const bf16*)(ws + WS_GATES); bf16* y = (bf16*)(ws + WS_Y);
    #pragma unroll
    for (int bj = 0; bj < 2; ++bj)
    #pragma unroll
    for (int n = 0; n < 2; ++n) {
      const int col = bcol + bj * 128 + wc * 32 + n * 16 + fq * 4;
      #pragma unroll
      for (int ai = 0; ai < 2; ++ai)
      #pragma unroll
      for (int m = 0; m < 4; ++m) {
        const size_t row = brow + ai * 128 + wr * 64 + m * 16 + fr;
        const u32x2 gw = *reinterpret_cast<const u32x2*>(gates + row * 3072 + br * 1024 + col);
        f32x4 a = acc[ai][bj][m][n], v;
        v[0] = bflo(gw[0]) * a[0]; v[1] = bfhi(gw[0]) * a[1]; v[2] = bflo(gw[1]) * a[2]; v[3] = bfhi(gw[1]) * a[3];
        if (br < 2) {
          const u32x2 gn = *reinterpret_cast<const u32x2*>(gates + row * 3072 + (br + 1) * 1024 + col);
          v[0] *= __builtin_amdgcn_rcpf(bflo(gn[0])); v[1] *= __builtin_amdgcn_rcpf(bfhi(gn[0]));
          v[2] *= __builtin_amdgcn_rcpf(bflo(gn[1])); v[3] *= __builtin_amdgcn_rcpf(bfhi(gn[1]));
          acc[ai][bj][m][n] = v;
        } else st4bf(y + row * 1024 + col, v);
      }
    }
  }
};

#define KSWZ(row, colB) ((row) * 256 + ((colB) ^ (((row) & 7) << 4)))
#define SBAR() __builtin_amdgcn_sched_barrier(0)
constexpr int KVBLK = 64;
constexpr int SHM_V = KVBLK * 128 * 2, SHM_K = KVBLK * 128 * 2;
constexpr float ATT_THR = 8.f;
__device__ __forceinline__ int crow(int r, int hi) { return (r & 3) + 8 * (r >> 2) + 4 * hi; }

template <int MODE> struct ACfg;
template <> struct ACfg<0> { static constexpr int ND0 = 4, NDV = 4; static constexpr float SCALE = 0.125f; };
template <> struct ACfg<1> { static constexpr int ND0 = 6, NDV = 2; static constexpr float SCALE = 0.10206207261596575f; };

template <int MODE>
__device__ __forceinline__ void partialSM(f32x16& p0, f32x16& p1, float& m_reg, float& mn, float& alpha) {
  constexpr float SC = ACfg<MODE>::SCALE;
  constexpr float C = SC * 1.4426950408889634f;
  float pmax = p0[0];
  #pragma unroll
  for (int r = 1; r < 16; ++r) pmax = fmaxf(pmax, p0[r]);
  #pragma unroll
  for (int r = 0; r < 16; ++r) pmax = fmaxf(pmax, p1[r]);
  { auto rr = __builtin_amdgcn_permlane32_swap(__float_as_uint(pmax), __float_as_uint(pmax), false, false);
    pmax = fmaxf(__uint_as_float(rr[0]), __uint_as_float(rr[1])); }
  if (__builtin_expect(__all(pmax - m_reg <= ATT_THR / SC), 1)) { mn = m_reg; alpha = 1.f; }
  else { mn = fmaxf(m_reg, pmax); alpha = __builtin_amdgcn_exp2f((m_reg - mn) * C); m_reg = mn; }
  float mnC = -mn * C;
  #pragma unroll
  for (int r = 0; r < 16; ++r) p0[r] = fmaf(p0[r], C, mnC);
  #pragma unroll
  for (int r = 0; r < 16; ++r) p1[r] = fmaf(p1[r], C, mnC);
  #pragma unroll
  for (int r = 0; r < 16; ++r) p0[r] = __builtin_amdgcn_exp2f(p0[r]);
}
template <bool SUM>
__device__ __forceinline__ void finishSM(f32x16& p0, f32x16& p1, float alpha, float& l_reg, bf16x8& pa0, bf16x8& pa1, bf16x8& pa2, bf16x8& pa3) {
  #pragma unroll
  for (int r = 0; r < 16; ++r) p1[r] = __builtin_amdgcn_exp2f(p1[r]);
  if constexpr (SUM) {
    float ps = 0;
    #pragma unroll
    for (int r = 0; r < 16; ++r) ps += p0[r];
    #pragma unroll
    for (int r = 0; r < 16; ++r) ps += p1[r];
    { auto rr = __builtin_amdgcn_permlane32_swap(__float_as_uint(ps), __float_as_uint(ps), false, false);
      ps = __uint_as_float(rr[0]) + __uint_as_float(rr[1]); }
    l_reg = l_reg * alpha + ps;
  }
#define PK4(P, BASE, OUT) do { unsigned a0 = cvtpk(P[BASE + 0], P[BASE + 1]), a1 = cvtpk(P[BASE + 2], P[BASE + 3]);   \
    unsigned b0 = cvtpk(P[BASE + 4], P[BASE + 5]), b1 = cvtpk(P[BASE + 6], P[BASE + 7]);                              \
    auto r0 = __builtin_amdgcn_permlane32_swap(a0, b0, false, false); auto r1 = __builtin_amdgcn_permlane32_swap(a1, b1, false, false); \
    u32x4 w = {r0[0], r1[0], r0[1], r1[1]}; OUT = *reinterpret_cast<bf16x8*>(&w); } while (0)
  PK4(p0, 0, pa0); PK4(p0, 8, pa1); PK4(p1, 0, pa2); PK4(p1, 8, pa3);
#undef PK4
}
template <int MODE>
__device__ __forceinline__ void qkt(f32x16& p0, f32x16& p1, const char* Ks, const bf16x8* qr, int r32, int hi) {
  p0 = f32x16{}; p1 = f32x16{};
  #pragma unroll
  for (int d0 = 0; d0 < ACfg<MODE>::ND0; ++d0) { int cb = (d0 * 16 + hi * 8) * 2;
    bf16x8 b0 = *reinterpret_cast<const bf16x8*>(Ks + KSWZ(r32, cb));
    bf16x8 b1 = *reinterpret_cast<const bf16x8*>(Ks + KSWZ(32 + r32, cb));
    p0 = __builtin_amdgcn_mfma_f32_32x32x16_bf16(b0, qr[d0], p0, 0, 0, 0);
    p1 = __builtin_amdgcn_mfma_f32_32x32x16_bf16(b1, qr[d0], p1, 0, 0, 0); }
}
__device__ __forceinline__ int v_st(int k, int c) { const int kk = (k & ~0xC) | ((k & 4) << 1) | ((k & 8) >> 1); return ((kk >> 3) * 4 + (c >> 5)) * 512 + ((kk & 7) * 32 + (c & 31)) * 2; }
__device__ __forceinline__ int v_rd_base(int lane) { return ((lane & 3) << 3) | (((lane >> 2) & 3) << 6) | (((lane >> 4) & 1) << 5) | (((lane >> 5) & 1) << 8); }
constexpr int v_rd_off(int d0, int ks, int half) { return d0 * 512 + ks * 4096 + half * 2048; }
template <int OFF> __device__ __forceinline__ s16x4 tr_read(int vb) {
  s16x4 r; asm volatile("ds_read_b64_tr_b16 %0, %1 offset:%2" : "=&v"(r) : "v"(vb), "i"(OFF) : "memory"); return r;
}
template <int D0> __device__ __forceinline__ void pv_one(f32x16& od, int vb, bf16x8 pa0, bf16x8 pa1, bf16x8 pa2, bf16x8 pa3) {
  const s16x4 l0 = tr_read<v_rd_off(D0, 0, 0)>(vb), h0 = tr_read<v_rd_off(D0, 0, 1)>(vb), l1 = tr_read<v_rd_off(D0, 1, 0)>(vb), h1 = tr_read<v_rd_off(D0, 1, 1)>(vb);
  const s16x4 l2 = tr_read<v_rd_off(D0, 2, 0)>(vb), h2 = tr_read<v_rd_off(D0, 2, 1)>(vb), l3 = tr_read<v_rd_off(D0, 3, 0)>(vb), h3 = tr_read<v_rd_off(D0, 3, 1)>(vb);
  asm volatile("s_waitcnt lgkmcnt(0)" ::: "memory"); SBAR();
#define PK(L, H) (bf16x8){L[0], L[1], L[2], L[3], H[0], H[1], H[2], H[3]}
  od = __builtin_amdgcn_mfma_f32_32x32x16_bf16(pa0, PK(l0, h0), od, 0, 0, 0);
  od = __builtin_amdgcn_mfma_f32_32x32x16_bf16(pa1, PK(l1, h1), od, 0, 0, 0);
  od = __builtin_amdgcn_mfma_f32_32x32x16_bf16(pa2, PK(l2, h2), od, 0, 0, 0);
  od = __builtin_amdgcn_mfma_f32_32x32x16_bf16(pa3, PK(l3, h3), od, 0, 0, 0);
#undef PK
}
template <int MODE>
__device__ __forceinline__ void pv_all(f32x16* o, int vb, bf16x8 pa0, bf16x8 pa1, bf16x8 pa2, bf16x8 pa3) {
  pv_one<0>(o[0], vb, pa0, pa1, pa2, pa3); pv_one<1>(o[1], vb, pa0, pa1, pa2, pa3);
  if constexpr (ACfg<MODE>::NDV == 4) { pv_one<2>(o[2], vb, pa0, pa1, pa2, pa3); pv_one<3>(o[3], vb, pa0, pa1, pa2, pa3); }
  else {
    const bf16x8 ones = {16256, 16256, 16256, 16256, 16256, 16256, 16256, 16256};
    o[2] = __builtin_amdgcn_mfma_f32_32x32x16_bf16(pa0, ones, o[2], 0, 0, 0);
    o[2] = __builtin_amdgcn_mfma_f32_32x32x16_bf16(pa1, ones, o[2], 0, 0, 0);
    o[2] = __builtin_amdgcn_mfma_f32_32x32x16_bf16(pa2, ones, o[2], 0, 0, 0);
    o[2] = __builtin_amdgcn_mfma_f32_32x32x16_bf16(pa3, ones, o[2], 0, 0, 0);
  }
}

template <int MODE>
__device__ __forceinline__ void attn_body(const bf16* __restrict__ Qb, const bf16* __restrict__ Kp, const bf16* __restrict__ Kr, const bf16* __restrict__ Vp,
                                          int lat_row, int ctx_row, int nt_lat, int NT, f32x16* o, float& l_out, char* lds) {
  constexpr int ND0 = ACfg<MODE>::ND0, NDV = ACfg<MODE>::NDV, NACC = MODE ? 3 : 4;
  constexpr int LDQ = MODE ? 1536 : 1024, LDK = MODE ? 2048 : 1024;
  const int tid = otid(), wid = tid >> 6, lane = tid & 63, r32 = lane & 31, hi = lane >> 5;
  char* V_lds = lds; char* K_lds = lds + 2 * SHM_V;
  float* wsl = (float*)(lds + 2 * SHM_V + 2 * SHM_K) + wid * 64; float* al_l = wsl + 32;
  float m_reg = -1e30f, l_reg = 0;
  #pragma unroll
  for (int d = 0; d < NACC; ++d) { float zz = 0.f; asm volatile("" : "+v"(zz));
    _Pragma("unroll") for (int r = 0; r < 16; ++r) o[d][r] = zz; }
  bf16x8 qr[ND0];
  const bf16* Qw = Qb + (size_t)(wid * 32 + r32) * LDQ + hi * 8;
  #pragma unroll
  for (int d0 = 0; d0 < ND0; ++d0) qr[d0] = *reinterpret_cast<const bf16x8*>(Qw + d0 * 16);
  const int vb0 = (int)(uintptr_t)V_lds + v_rd_base(lane);
  const int kkey = tid >> 3, kpc = tid & 7;
  const int sr = tid >> 4, sc = (tid & 15) * 8;
  const int rkey = (tid >> 2) & 63, rpc = tid & 3;
  const int ks_off = KSWZ(kkey, kpc * 16), kr_off = KSWZ(rkey, 128 + rpc * 16);
  const int vst0 = MODE ? v_st(kkey, kpc * 8) : v_st(sr, sc), vst1 = v_st(32 + sr, sc);
  bf16x8 sa0, sb0, sc0, sa1, sb1, sc1;
#define KROW(j) ((j) < nt_lat ? lat_row + (j) * 64 : ctx_row + ((j) - nt_lat) * 64)
#define SLOAD(A_, B_, C_, j) do { const int kr0 = KROW(j); \
    if constexpr (MODE == 0) { A_ = *reinterpret_cast<const bf16x8*>(Kp + (size_t)(kr0 + kkey) * LDK + kpc * 8); \
      B_ = *reinterpret_cast<const bf16x8*>(Vp + (size_t)(kr0 + sr) * LDK + sc); C_ = *reinterpret_cast<const bf16x8*>(Vp + (size_t)(kr0 + 32 + sr) * LDK + sc); } \
    else { A_ = *reinterpret_cast<const bf16x8*>(Kp + (size_t)(kr0 + kkey) * LDK + kpc * 8); \
      B_ = *reinterpret_cast<const bf16x8*>(Vp + (size_t)(kr0 + kkey) * LDK + kpc * 8); C_ = *reinterpret_cast<const bf16x8*>(Kr + (size_t)(kr0 + rkey) * 32 + rpc * 8); } } while (0)
#define SWRITE(b, A_, B_, C_) do { *reinterpret_cast<bf16x8*>(K_lds + (b) * SHM_K + ks_off) = A_; \
    if constexpr (MODE == 0) { *reinterpret_cast<bf16x8*>(V_lds + (b) * SHM_V + vst0) = B_; *reinterpret_cast<bf16x8*>(V_lds + (b) * SHM_V + vst1) = C_; } \
    else { *reinterpret_cast<bf16x8*>(V_lds + (b) * SHM_V + vst0) = B_; *reinterpret_cast<bf16x8*>(K_lds + (b) * SHM_K + kr_off) = C_; } } while (0)
#define SWAIT() asm volatile("s_waitcnt vmcnt(3)" ::: "memory")
#define RESC(a) do { if (__any((a) < 1.f)) { if (hi == 0) al_l[r32] = (a); asm volatile("s_waitcnt lgkmcnt(0)" ::: "memory"); \
    _Pragma("unroll") for (int d = 0; d < NACC; ++d) _Pragma("unroll") for (int r = 0; r < 16; ++r) o[d][r] *= al_l[crow(r, hi)]; } } while (0)
  f32x16 pA0, pA1, pB0, pB1; float mnA, mnB, alA, alB; bf16x8 pa0, pa1, pa2, pa3;
  SLOAD(sa0, sb0, sc0, 0); asm volatile("s_waitcnt vmcnt(0)" ::: "memory"); SWRITE(0, sa0, sb0, sc0); __syncthreads();
  qkt<MODE>(pA0, pA1, K_lds, qr, r32, hi); partialSM<MODE>(pA0, pA1, m_reg, mnA, alA);
  SLOAD(sa1, sb1, sc1, 1); if (2 < NT) SLOAD(sa0, sb0, sc0, 2);
  SWAIT(); SWRITE(1, sa1, sb1, sc1); __syncthreads();
  for (int j = 1; j + 1 < NT; j += 2) {
    SBAR(); qkt<MODE>(pB0, pB1, K_lds + SHM_K, qr, r32, hi);
    finishSM<MODE == 0>(pA0, pA1, alA, l_reg, pa0, pa1, pa2, pa3); SBAR();
    SLOAD(sa1, sb1, sc1, j + 2); SBAR();
    pv_all<MODE>(o, vb0, pa0, pa1, pa2, pa3); partialSM<MODE>(pB0, pB1, m_reg, mnB, alB);
    __syncthreads(); SWAIT(); SWRITE(0, sa0, sb0, sc0);
    RESC(alB); __syncthreads();
    SBAR(); qkt<MODE>(pA0, pA1, K_lds, qr, r32, hi);
    finishSM<MODE == 0>(pB0, pB1, alB, l_reg, pa0, pa1, pa2, pa3); SBAR();
    if (j + 3 < NT) SLOAD(sa0, sb0, sc0, j + 3); SBAR();
    pv_all<MODE>(o, vb0 + SHM_V, pa0, pa1, pa2, pa3); partialSM<MODE>(pA0, pA1, m_reg, mnA, alA);
    __syncthreads(); SWAIT(); SWRITE(1, sa1, sb1, sc1);
    RESC(alA); __syncthreads();
  }
  SBAR(); qkt<MODE>(pB0, pB1, K_lds + SHM_K, qr, r32, hi);
  finishSM<MODE == 0>(pA0, pA1, alA, l_reg, pa0, pa1, pa2, pa3); SBAR();
  pv_all<MODE>(o, vb0, pa0, pa1, pa2, pa3); partialSM<MODE>(pB0, pB1, m_reg, mnB, alB);
  __syncthreads(); RESC(alB);
  finishSM<MODE == 0>(pB0, pB1, alB, l_reg, pa0, pa1, pa2, pa3); SBAR();
  pv_all<MODE>(o, vb0 + SHM_V, pa0, pa1, pa2, pa3);
  l_out = l_reg;
  __syncthreads();
#undef KROW
#undef SLOAD
#undef SWRITE
#undef SWAIT
#undef RESC
}

__device__ __forceinline__ void diff_unit(unsigned char* ws, int qrow0, int h, int lat_row, int ctx_row, int nt_lat, int NT,
                                          float lam, float oscale, const float* subln, char* lds, bool dry = false) {
  const int tid = otid(), wid = tid >> 6, lane = tid & 63, r32 = lane & 31, hi = lane >> 5;
  bf16* qb = (bf16*)(ws + WS_QB); const bf16* kb = (const bf16*)(ws + WS_KB); const bf16* vb = (const bf16*)(ws + WS_VB);
  float* stash = (float*)(ws + WS_YTMP);
  float* li_l = (float*)(lds + 2 * SHM_V + 2 * SHM_K) + wid * 64;
  #pragma unroll 1
  for (int mp = 0; mp < 2; ++mp) {
    f32x16 o[4]; float l_reg;
    attn_body<0>(qb + (size_t)qrow0 * 1024 + h * 128 + mp * 64, kb + h * 128 + mp * 64, nullptr, vb + h * 128, lat_row, ctx_row, nt_lat, NT, o, l_reg, lds);
    if (hi == 0) li_l[r32] = l_reg;
    asm volatile("s_waitcnt lgkmcnt(0)" ::: "memory");
    __attribute__((address_space(1))) char* sq = (__attribute__((address_space(1))) char*)(stash + (size_t)(qrow0 + wid * 32 + hi * 4) * 1024 + h * 128 + r32);
    if (mp == 0) {
      #pragma unroll
      for (int r = 0; r < 16; ++r) { const float rl = __builtin_amdgcn_rcpf(li_l[crow(r, hi)]);
        asm volatile("" : "+v"(sq));
        #pragma unroll
        for (int d0 = 0; d0 < 4; ++d0) ((__attribute__((address_space(1))) float*)sq)[d0 * 32] = o[d0][r] * rl;
        sq += ((r & 3) == 3 ? 5 : 1) * 4096; }
    } else {
      __attribute__((address_space(1))) char* oq = (__attribute__((address_space(1))) char*)(qb + (size_t)(qrow0 + wid * 32 + hi * 4) * 1024 + h * 128 + r32);
      float g4[4];
      #pragma unroll
      for (int d0 = 0; d0 < 4; ++d0) g4[d0] = subln[d0 * 32 + r32] * oscale;
      #pragma unroll
      for (int r = 0; r < 16; ++r) { const float rl = __builtin_amdgcn_rcpf(li_l[crow(r, hi)]);
        asm volatile("" : "+v"(sq)); asm volatile("" : "+v"(oq));
        float d[4]; float ss = 0.f;
        #pragma unroll
        for (int d0 = 0; d0 < 4; ++d0) { d[d0] = ((const __attribute__((address_space(1))) float*)sq)[d0 * 32] - lam * (o[d0][r] * rl); ss += d[d0] * d[d0]; }
        ss = DPP_ADD(ss, 0xB1); ss = DPP_ADD(ss, 0x4E); ss = DPP_ADD(ss, 0x141); ss = DPP_ADD(ss, 0x140); ss += shx(ss, 16);
        const float rn = rsqrtf(ss * (1.f / 128.f) + EPS);
        if (!dry) { _Pragma("unroll") for (int d0 = 0; d0 < 4; ++d0) ((__attribute__((address_space(1))) u16*)oq)[d0 * 32] = f2bf(d[d0] * rn * g4[d0]); }
        sq += ((r & 3) == 3 ? 5 : 1) * 4096; oq += ((r & 3) == 3 ? 5 : 1) * 2048; }
    }
    __syncthreads();
  }
}
__device__ __forceinline__ void mla_unit(unsigned char* ws, int qrow0, int h, int lat_row, int ctx_row, int nt_lat, int NT, char* lds) {
  const int tid = otid(), wid = tid >> 6, lane = tid & 63, r32 = lane & 31, hi = lane >> 5;
  const bf16* qc = (const bf16*)(ws + WS_QC); const bf16* kvc = (const bf16*)(ws + WS_KVC); const bf16* kr = (const bf16*)(ws + WS_KR);
  bf16* oc = (bf16*)(ws + WS_OC);
  float* li_l = (float*)(lds + 2 * SHM_V + 2 * SHM_K) + wid * 64;
  f32x16 o[3]; float l_reg;
  attn_body<1>(qc + (size_t)qrow0 * 1536 + h * 96, kvc + h * 128, kr, kvc + h * 128 + 64, lat_row, ctx_row, nt_lat, NT, o, l_reg, lds);
  __attribute__((address_space(1))) char* oq = (__attribute__((address_space(1))) char*)(oc + (size_t)(qrow0 + wid * 32 + hi * 4) * 1024 + h * 64 + r32);
  #pragma unroll
  for (int r = 0; r < 16; ++r) { const float rl = __builtin_amdgcn_rcpf(o[2][r]);
    asm volatile("" : "+v"(oq));
    #pragma unroll
    for (int d0 = 0; d0 < 2; ++d0) ((__attribute__((address_space(1))) u16*)oq)[d0 * 32] = f2bf(o[d0][r] * rl);
    oq += ((r & 3) == 3 ? 5 : 1) * 2048; }
  __syncthreads();
}

__device__ __forceinline__ void sg_unit(unsigned char* ws, bf16* oa_base, int chunk, int g, const float* lng, const float* lnb, const float* spw, const float* spb, char* lds) {
  const int tid = otid(), wid = tid >> 6, lane = tid & 63, fr = lane & 15, fq = lane >> 4;
  bf16* ga = (bf16*)(ws + WS_GA) + (size_t)chunk * 128 * 2048;
  constexpr int LDT = 136;
  u16* wS = (u16*)lds;
  u16* vT = (u16*)(lds + 128 * LDT * 2);
  float* mu = (float*)(lds + 2 * 128 * LDT * 2); float* rs = mu + 128;
  #pragma unroll 1
  for (int i0 = 0; i0 < 16; i0 += 4) {
    bf16x8 a[4], b[4];
    #pragma unroll
    for (int q = 0; q < 4; ++q) { const bf16* vp = ga + (size_t)(wid * 16 + i0 + q) * 2048 + 1024 + lane * 16;
      a[q] = *reinterpret_cast<const bf16x8*>(vp); b[q] = *reinterpret_cast<const bf16x8*>(vp + 8); }
    #pragma unroll
    for (int q = 0; q < 4; ++q) {
      float x[16];
      #pragma unroll
      for (int k = 0; k < 8; ++k) { x[k] = bf2f((u16)a[q][k]); x[8 + k] = bf2f((u16)b[q][k]); }
      float s = 0.f;
      #pragma unroll
      for (int k = 0; k < 16; ++k) s += x[k];
      s = wave_sum(s);
      const float mean = s * (1.f / 1024.f);
      float qq = 0.f;
      #pragma unroll
      for (int k = 0; k < 16; ++k) { float d = x[k] - mean; qq += d * d; }
      qq = wave_sum(qq);
      if (lane == 0) { mu[wid * 16 + i0 + q] = mean; rs[wid * 16 + i0 + q] = rsqrtf(qq * (1.f / 1024.f) + EPS); }
    }
  }
  #pragma unroll
  for (int it = 0; it < 8; ++it) { const int idx = tid + it * NTHR;
    const int i = idx >> 5, j4 = (idx & 31) * 4;
    f32x4 w = *reinterpret_cast<const f32x4*>(spw + (size_t)g * 16384 + i * 128 + j4);
    u32x2 pk = {cvtpk(w[0], w[1]), cvtpk(w[2], w[3])};
    *reinterpret_cast<u32x2*>(wS + i * LDT + j4) = pk;
  }
  __syncthreads();
  #pragma unroll
  for (int it = 0; it < 4; ++it) { const int idx = tid + it * NTHR;
    const int j = idx & 127, c8 = (idx >> 7) * 8;
    bf16x8 v = *reinterpret_cast<const bf16x8*>(ga + (size_t)j * 2048 + 1024 + g * 128 + c8);
    const float m_ = mu[j], r_ = rs[j];
    #pragma unroll
    for (int k = 0; k < 8; ++k) { const int c = c8 + k;
      float y = (bf2f((u16)v[k]) - m_) * r_ * lng[g * 128 + c] + lnb[g * 128 + c];
      vT[c * LDT + j] = f2bf(y); }
  }
  __syncthreads();
  bf16x8 af[4];
  #pragma unroll
  for (int k = 0; k < 4; ++k) af[k] = *reinterpret_cast<const bf16x8*>(wS + (wid * 16 + fr) * LDT + k * 32 + fq * 8);
  u16 uv[8][4];
  #pragma unroll
  for (int cb = 0; cb < 8; ++cb)
  #pragma unroll
  for (int j = 0; j < 4; ++j) uv[cb][j] = *reinterpret_cast<const u16*>(ga + (size_t)(wid * 16 + fq * 4 + j) * 2048 + g * 128 + cb * 16 + fr);
  #pragma unroll
  for (int cb = 0; cb < 8; ++cb) {
    f32x4 acc = {0.f, 0.f, 0.f, 0.f};
    #pragma unroll
    for (int k = 0; k < 4; ++k) {
      bf16x8 bfr = *reinterpret_cast<const bf16x8*>(vT + (cb * 16 + fr) * LDT + k * 32 + fq * 8);
      acc = __builtin_amdgcn_mfma_f32_16x16x32_bf16(af[k], bfr, acc, 0, 0, 0);
    }
    #pragma unroll
    for (int j = 0; j < 4; ++j) {
      const int i = wid * 16 + fq * 4 + j;
      const float z = acc[j] + spb[g * 128 + i];
      *reinterpret_cast<u16*>(oa_base + ((size_t)chunk * 128 + i) * 1024 + g * 128 + cb * 16 + fr) = f2bf(bf2f(uv[cb][j]) * z);
    }
  }
  __syncthreads();
}

__device__ __forceinline__ int perm_col(int ptype, int n) {
  if (ptype == 1) { int t = n / DFF, c = n - t * DFF; return 256 * (c >> 7) + 128 * t + (c & 127); }
  if (ptype == 2 && n >= 2048 && n < 4096) { int d = n & 63; int s = d >> 5, c = (d >> 4) & 1, i = d & 15; return (n & ~63) + c * 32 + s * 16 + i; }
  return n;
}
__device__ __forceinline__ void tconv_tile(const float* __restrict__ src, int N, int k0, int n0, bf16* __restrict__ dst, int K, int ptype, const float* kscale, float* tl) {
  const int tid = otid();
  #pragma unroll
  for (int i = 0; i < 2; ++i) {
    const int idx = tid + i * NTHR, kk = idx >> 4, c4 = (idx & 15) * 4;
    float zz = 0.f; asm volatile("" : "+v"(zz));
    f32x4 v = {zz, zz, zz, zz};
    if (n0 + c4 < N) v = *reinterpret_cast<const f32x4*>(src + (size_t)(k0 + kk) * N + n0 + c4);
    if (kscale) { const float s = kscale[k0 + kk]; v[0] *= s; v[1] *= s; v[2] *= s; v[3] *= s; }
    tl[kk * 65 + c4 + 0] = v[0]; tl[kk * 65 + c4 + 1] = v[1]; tl[kk * 65 + c4 + 2] = v[2]; tl[kk * 65 + c4 + 3] = v[3];
  }
  __syncthreads();
  { const int nn = tid >> 3, kg = (tid & 7) * 8;
    if (n0 + nn < N) {
      u32x4 w;
      w[0] = cvtpk(tl[(kg + 0) * 65 + nn], tl[(kg + 1) * 65 + nn]); w[1] = cvtpk(tl[(kg + 2) * 65 + nn], tl[(kg + 3) * 65 + nn]);
      w[2] = cvtpk(tl[(kg + 4) * 65 + nn], tl[(kg + 5) * 65 + nn]); w[3] = cvtpk(tl[(kg + 6) * 65 + nn], tl[(kg + 7) * 65 + nn]);
      *reinterpret_cast<u32x4*>(dst + (size_t)perm_col(ptype, n0 + nn) * K + k0 + kg) = w;
    } }
  __syncthreads();
}
struct ConvJob { const float* src; bf16* dst; const float* kscale; int K, N, ptype; };
__device__ __forceinline__ ConvJob conv_job(const Params& p, int l, int j) {
  ConvJob c; c.kscale = nullptr; c.ptype = 0;
  unsigned char* wl = p.ws + WS_W + (size_t)l * W_LAYER;
  switch (j) {
    case 0: c.src = p.in[I_F1W13] + (size_t)l * 1024 * 5632; c.dst = (bf16*)(wl + WO_W13A); c.K = 1024; c.N = 5632; c.ptype = 1; break;
    case 1: c.src = p.in[I_F1W2] + (size_t)l * 2816 * 1024; c.dst = (bf16*)(wl + WO_W2A); c.K = 2816; c.N = 1024; break;
    case 2: c.src = p.in[I_F2W13] + (size_t)l * 1024 * 5632; c.dst = (bf16*)(wl + WO_W13B); c.K = 1024; c.N = 5632; c.ptype = 1; break;
    case 3: c.src = p.in[I_F2W2] + (size_t)l * 2816 * 1024; c.dst = (bf16*)(wl + WO_W2B); c.K = 2816; c.N = 1024; break;
    case 4: c.src = p.in[I_WIN] + (size_t)l * 1024 * NWIN; c.dst = (bf16*)(wl + WO_WIN); c.K = 1024; c.N = NWIN; c.ptype = 2; break;
    case 5: c.src = p.in[I_WUQ] + (size_t)l * 512 * 1536; c.dst = (bf16*)(wl + WO_WUQ); c.K = 512; c.N = 1536; c.kscale = p.in[I_QNG] + l * 512; break;
    case 6: c.src = p.in[I_WUKV] + (size_t)l * 256 * 2048; c.dst = (bf16*)(wl + WO_WUKV); c.K = 256; c.N = 2048; c.kscale = p.in[I_KVNG] + l * 256; break;
    case 7: case 8: case 9: c.src = p.in[I_WBR] + ((size_t)l * 3 + (j - 7)) * 1024 * 1024; c.dst = (bf16*)(wl + WO_WBR) + (size_t)(j - 7) * 1024 * 1024; c.K = 1024; c.N = 1024; break;
    default: c.src = p.in[I_WOUT] + (size_t)l * 1024 * 1024; c.dst = (bf16*)(wl + WO_WOUT); c.K = 1024; c.N = 1024; break;
  }
  return c;
}

__device__ __forceinline__ void conv_layer(const Params& p, int l, int part, int nparts, int worker, int nworkers, char* lds, int j0 = 0, int j1 = 11) {
  float* tl = (float*)lds; int base = 0;
  const int s = nparts * nworkers, r = part + nparts * worker;
  for (int j = j0; j < j1; ++j) {
    ConvJob c = conv_job(p, l, j);
    const int nk = c.K / 64, nn = (c.N + 63) / 64, ntile = nk * nn;
    for (int t = (((r - base) % s) + s) % s; t < ntile; t += s) { const int tn = t / nk, tk = t - tn * nk; tconv_tile(c.src, c.N, tk * 64, tn * 64, c.dst, c.K, c.ptype, c.kscale, tl); }
    base += ntile;
  }
}
__device__ __forceinline__ void phase_prep(const Params& p, char* lds) {
  const int tid = otid(), G = ogx(), bx = obx();
  const long gtid = (long)bx * NTHR + tid, gsz = (long)G * NTHR;
  { float* cosb = (float*)(p.ws + WS_COSB); float* sinb = (float*)(p.ws + WS_SINB);
    for (long i = gtid; i < 4096 * 32; i += gsz) { int t = (int)(i >> 5), f = (int)(i & 31);
      float fr = powf(10000.f, -(float)(f & 15) / 16.f); float ang = (float)(f < 16 ? (t >> 6) : (t & 63)) * fr;
      cosb[i] = cosf(ang); sinb[i] = sinf(ang); }
    float* cosc = (float*)(p.ws + WS_COSC); float* sinc = (float*)(p.ws + WS_SINC);
    for (long i = gtid; i < 4096 * 16; i += gsz) { int t = (int)(i >> 4), f = (int)(i & 15);
      float fr = powf(10000.f, -(float)(f & 7) / 8.f); float ang = (float)(f < 8 ? (t >> 6) : (t & 63)) * fr;
      cosc[i] = cosf(ang); sinc[i] = sinf(ang); } }
  if (bx == 0 && tid < 128) {
    const int l = tid >> 6, k = tid & 63;
    float a = p.in[I_LQ1][l * 64 + k] * p.in[I_LK1][l * 64 + k], b = p.in[I_LQ2][l * 64 + k] * p.in[I_LK2][l * 64 + k];
    #pragma unroll
    for (int o = 1; o < 64; o <<= 1) { a += shx(a, o); b += shx(b, o); }
    if (k == 0) { const float lam_init = 0.8f - 0.6f * expf(-0.3f * (float)l); ((float*)(p.ws + WS_LAM))[l] = expf(a) - expf(b) + lam_init; }
  }
  for (int l = 0; l < 2; ++l) { u32x4* z = (u32x4*)(p.ws + WS_W + (size_t)l * W_LAYER + WO_WIN + (size_t)NWIN * 1024 * 2);
    unsigned z0 = 0; asm volatile("" : "+v"(z0));
    for (long i = gtid; i < (long)(NWINP - NWIN) * 1024 * 2 / 16; i += gsz) z[i] = u32x4{z0, z0, z0, z0}; }
  { float* sl = (float*)lds;
    float* red = sl + 9 * 1024;
    float* mod = (float*)(p.ws + WS_MOD);
    if (bx < 2 * 144) {
      for (int i = tid; i < 9 * 1024; i += NTHR) sl[i] = siluf_(i < 8192 ? p.in[I_C][i] : p.in[I_CCTX][i - 8192]);
      __syncthreads();
    }
    const int col = tid & 63, kg = tid >> 6;
    for (int it = bx; it < 2 * 144; it += G) {
      const int l = it / 144, n0 = (it % 144) * 64;
      const float* W = p.in[I_ADAW] + (size_t)l * 1024 * 9216 + n0 + col;
      float acc[9];
      #pragma unroll
      for (int j = 0; j < 9; ++j) acc[j] = 0.f;
      for (int k = kg * 128; k < kg * 128 + 128; ++k) {
        const float w = W[(size_t)k * 9216];
        #pragma unroll
        for (int j = 0; j < 9; ++j) acc[j] += sl[j * 1024 + k] * w;
      }
      #pragma unroll
      for (int j = 0; j < 9; ++j) red[(kg * 9 + j) * 64 + col] = acc[j];
      __syncthreads();
      for (int o = tid; o < 9 * 64; o += NTHR) { const int j = o >> 6, c = o & 63; float sm = 0.f;
        #pragma unroll
        for (int q = 0; q < 8; ++q) sm += red[(q * 9 + j) * 64 + c];
        mod[((size_t)l * 9 + j) * 9216 + n0 + c] = sm + p.in[I_ADAB][l * 9216 + n0 + c]; }
      __syncthreads();
    } }
  if (G == 256) conv_layer(p, 0, 0, 1, bx, G, lds, 0, 2);
  else { conv_layer(p, 0, 0, 1, bx, G, lds); conv_layer(p, 1, 0, 1, bx, G, lds); }
}

__device__ __forceinline__ void phase_norm(const Params& p, int l, int which) {
  const int tid_ = otid(); const int wid = tid_ >> 6, lane = tid_ & 63;
  const float* gain = p.in[which == 0 ? I_NFFN1 : (which == 1 ? I_NMIX : I_NFFN2)] + l * 1024;
  const float* mod = (const float*)(p.ws + WS_MOD) + (size_t)l * 9 * 9216;
  bf16* h = (bf16*)(p.ws + WS_H);
  for (int r0 = (obx() * 8 + wid) * 2; r0 < R_ALL; r0 += ogx() * 16) {
    const int rb = r0 & ~127;
    TileInfo ti = (l == 0 && which == 0) ? tile_info(rb, const_cast<float*>(p.in[I_X]), const_cast<float*>(p.in[I_CTX])) : tile_info(rb, p.out, (float*)(p.ws + WS_CTXRES));
    const float* x = ti.resid + (size_t)(r0 - rb) * DM;
    const float* sh = mod + (size_t)ti.mi * 9216 + (which * 3) * 1024; const float* sc = sh + 1024;
    f32x4 v[2][4]; float ss[2] = {0.f, 0.f};
    #pragma unroll
    for (int q = 0; q < 2; ++q)
    #pragma unroll
    for (int i = 0; i < 4; ++i) v[q][i] = *(const __attribute__((address_space(1))) f32x4*)(x + q * DM + i * 256 + lane * 4);
    #pragma unroll
    for (int q = 0; q < 2; ++q)
    #pragma unroll
    for (int i = 0; i < 4; ++i) ss[q] += v[q][i][0] * v[q][i][0] + v[q][i][1] * v[q][i][1] + v[q][i][2] * v[q][i][2] + v[q][i][3] * v[q][i][3];
    ss[0] = wave_sum(ss[0]); ss[1] = wave_sum(ss[1]);
    #pragma unroll
    for (int i = 0; i < 4; ++i) { const int c = i * 256 + lane * 4;
      f32x4 g = *reinterpret_cast<const f32x4*>(gain + c), s1 = *reinterpret_cast<const f32x4*>(sc + c), s0 = *reinterpret_cast<const f32x4*>(sh + c);
      #pragma unroll
      for (int q = 0; q < 2; ++q) { const float rn = rsqrtf(ss[q] * (1.f / 1024.f) + EPS); f32x4 y;
        #pragma unroll
        for (int j = 0; j < 4; ++j) y[j] = v[q][i][j] * rn * g[j] * (1.f + s1[j]) + s0[j];
        st4bf(h + (size_t)(r0 + q) * 1024 + c, y); } }
  }
}
__device__ __forceinline__ void phase_final(const Params& p) {
  const int tid_ = otid(); const int wid = tid_ >> 6, lane = tid_ & 63;
  const float* gain = p.in[I_NFINAL];
  for (int r = obx() * 8 + wid; r < NB * SEQ; r += ogx() * 8) {
    float* x = p.out + (size_t)r * DM;
    f32x4 v[4]; float ss = 0.f;
    #pragma unroll
    for (int i = 0; i < 4; ++i) { v[i] = *reinterpret_cast<const f32x4*>(x + i * 256 + lane * 4);
      ss += v[i][0] * v[i][0] + v[i][1] * v[i][1] + v[i][2] * v[i][2] + v[i][3] * v[i][3]; }
    ss = wave_sum(ss);
    const float rn = rsqrtf(ss * (1.f / 1024.f) + EPS);
    #pragma unroll
    for (int i = 0; i < 4; ++i) { const int c = i * 256 + lane * 4;
      f32x4 g = *reinterpret_cast<const f32x4*>(gain + c), y;
      #pragma unroll
      for (int j = 0; j < 4; ++j) y[j] = v[i][j] * rn * g[j];
      *reinterpret_cast<f32x4*>(x + c) = y; }
  }
}

__device__ __forceinline__ void phase_ffn_up(const Params& p, int l, int which, char* lds) {
  GridSched S{(const char*)(p.ws + WS_H), (const char*)(p.ws + WS_W + (size_t)l * W_LAYER + (which ? WO_W13B : WO_W13A)), (l == 1 && which == 1) ? 128 : R_ALL / 256, 5632 / 256, ogx(), obx(), (size_t)256 * 1024 * 2, 1, (l == 1 && which == 1)};
  EpiSwiglu E{(bf16*)(p.ws + WS_ACT)};
  gemm_phase((LAS unsigned char*)lds, 1024, S, E);
}
__device__ __forceinline__ void phase_ffn_down(const Params& p, int l, int which, char* lds) {
  GridSched S{(const char*)(p.ws + WS_ACT), (const char*)(p.ws + WS_W + (size_t)l * W_LAYER + (which ? WO_W2B : WO_W2A)), (l == 1 && which == 1) ? 128 : R_ALL / 256, 4, ogx(), obx(), (size_t)256 * DFF * 2, 1, (l == 1 && which == 1)};
  EpiResid E{p.out, (float*)(p.ws + WS_CTXRES), (const float*)(p.ws + WS_MOD) + (size_t)l * 9 * 9216 + (which ? 8 : 2) * 1024, 0.5f, 0, 0, (l == 0 && which == 0) ? p.in[I_X] : p.out, (l == 0 && which == 0) ? p.in[I_CTX] : (const float*)(p.ws + WS_CTXRES)};
#ifdef REP_RESID
  { EpiResid E2 = E; E2.dry = 1; gemm_phase((LAS unsigned char*)lds, DFF, S, E2); }
#endif
  gemm_phase((LAS unsigned char*)lds, DFF, S, E);
  { const int G = ogx(), bx = obx(); if (l == 0 && which == 0 && G == 256 && bx >= 32) conv_layer(p, 0, 0, 1, bx - 32, G - 32, lds, 2, 11); }
}
__device__ __forceinline__ void phase_win(const Params& p, int l, int g, char* lds) {
  GridSched S{(const char*)(p.ws + WS_H + (size_t)g * GR * 1024 * 2), (const char*)(p.ws + WS_W + (size_t)l * W_LAYER + WO_WIN), GR / 256, NWINP / 256, ogx(), obx(), (size_t)256 * 1024 * 2, 1, 0};
  EpiWin E{p.ws, p.in[I_BGATE] + l * 3072, g * GR};
  gemm_phase((LAS unsigned char*)lds, 1024, S, E);
}
__device__ __forceinline__ void phase_up(const Params& p, int l, int g, char* lds) {
  const int G = ogx(), bx = obx();
  { GridSched S{(const char*)(p.ws + WS_CQ), (const char*)(p.ws + WS_W + (size_t)l * W_LAYER + WO_WUQ), GR / 256, 6, G, bx, (size_t)256 * 512 * 2, 0, 0};
    EpiUp<1> E{p.ws, g * GR}; gemm_phase((LAS unsigned char*)lds, 512, S, E); }
  { GridSched S{(const char*)(p.ws + WS_CKV), (const char*)(p.ws + WS_W + (size_t)l * W_LAYER + WO_WUKV), GR / 256, 8, G, (bx + G - (204 % G)) % G, (size_t)256 * 256 * 2, 0, 0};
    EpiUp<0> E{p.ws, g * GR}; gemm_phase((LAS unsigned char*)lds, 256, S, E); }
}
__device__ __forceinline__ void phase_merge(const Params& p, int l, int g, char* lds) {
  MergeSched S{(const char*)(p.ws + WS_H + (size_t)g * GR * 1024 * 2), (const char*)(p.ws + WS_QB), (const char*)(p.ws + WS_OC),
               (const char*)(p.ws + WS_W + (size_t)l * W_LAYER + WO_WBR), GR / 256, 4, ogx(), obx()};
  EpiMerge E{p.ws};
  gemm_phase<EpiMerge, MergeSched, true>((LAS unsigned char*)lds, 1024, S, E);
  { const int G = ogx(), bx = obx(); if (l == 0 && G == 256 && bx >= 136) conv_layer(p, 1, g, 4, bx - 136, G - 136, lds); }
}
__device__ __forceinline__ void phase_wout(const Params& p, int l, int g, char* lds) {
  const int G = ogx();
  GridSched S{(const char*)(p.ws + WS_Y), (const char*)(p.ws + WS_W + (size_t)l * W_LAYER + WO_WOUT), GR / 256, 4, G, (obx() + G - (120 % G)) % G, (size_t)256 * 1024 * 2, 2, 0};
  EpiResid E{p.out, (float*)(p.ws + WS_CTXRES), (const float*)(p.ws + WS_MOD) + (size_t)l * 9 * 9216 + 5 * 1024, 1.0f, g * GR, 0, p.out, (const float*)(p.ws + WS_CTXRES)};
#ifdef REP_RESID
  { EpiResid E2 = E; E2.dry = 1; gemm_phase((LAS unsigned char*)lds, 1024, S, E2); }
#endif
  gemm_phase((LAS unsigned char*)lds, 1024, S, E);
}

__device__ __forceinline__ void phase_mix(const Params& p, int l, int g, char* lds) {
  const float lam = ((const float*)(p.ws + WS_LAM))[l];
  const float lam_init = 0.8f - 0.6f * expf(-0.3f * (float)l);
  const float* subln = p.in[I_SUBLN] + l * 128;
  const int nctx = (l == 0) ? 48 : 0;
  const int nchunk = (l == 0 ? 68 : 64);
  const int nsg = ((nchunk + 7) / 8) * 64;
  const int total = 256 + 512 + nctx + nsg;
  for (int it = obx(); it < total; it += ogx()) {
#ifndef MIXM
#define MIXM 7
#endif
    if (it < 256) { if (!(MIXM & 1)) continue; const int pr = (it & 7) * 2 + (it >> 7), qb = (it >> 3) & 15; const int bb = pr >> 3, h = pr & 7;
#ifdef REP_DIFF
      diff_unit(p.ws, bb * 4096 + qb * 256, h, bb * 4096, GLAT + bb * 256, 64, 68, lam, 1.f - lam_init, subln, lds, true);
#endif
      diff_unit(p.ws, bb * 4096 + qb * 256, h, bb * 4096, GLAT + bb * 256, 64, 68, lam, 1.f - lam_init, subln, lds);
    } else if (it < 768) { if (!(MIXM & 2)) continue; const int i2 = it - 256; const int pr = (i2 >> 8) * 16 + (i2 & 7) * 2 + ((i2 >> 7) & 1), qb = (i2 >> 3) & 15; const int bb = pr >> 4, h = pr & 15;
      for (int rep = 0; rep < REP_MLA; ++rep) mla_unit(p.ws, bb * 4096 + qb * 256, h, bb * 4096, GLAT + bb * 256, 64, 68, lds);
    } else if (it < 768 + nctx) { const int i3 = it - 768;
      if (i3 < 16) { if (!(MIXM & 1)) continue; const int bb = i3 >> 3, h = i3 & 7; diff_unit(p.ws, GLAT + bb * 256, h, 0, GLAT + bb * 256, 0, 4, lam, 1.f - lam_init, subln, lds); }
      else { if (!(MIXM & 2)) continue; const int i4 = i3 - 16; const int bb = i4 >> 4, h = i4 & 15; mla_unit(p.ws, GLAT + bb * 256, h, 0, GLAT + bb * 256, 0, 4, lds); }
    } else { if (!(MIXM & 4)) continue; const int ch = it - 768 - nctx;
      const int sx = ch & 7, sk = ch >> 3, schunk = (sk >> 3) * 8 + sx; if (schunk >= nchunk) continue;
      sg_unit(p.ws, (bf16*)(p.ws + WS_H) + (size_t)g * GR * 1024, schunk, sk & 7, p.in[I_LNVG] + l * 1024, p.in[I_LNVB] + l * 1024, p.in[I_SPW] + (size_t)l * 8 * 16384, p.in[I_SPB] + l * 1024, lds);
    }
  }
}

#define XB_TMO      128
#define XB_XCNT(j)  (256  + 64 * (j))
#define XB_XSUB(j)  (1280 + 64 * (j))
#define XB_XGEN(j)  (2304 + 64 * (j))
#define XB_TOP      3328
#define XB_TOPGEN   3392
#define XCD_BAR_WORDS 3456
#define XB_SPIN_CAP (1u << 20)
__device__ __forceinline__ unsigned xb_ld(unsigned* p)              { return __hip_atomic_load(p, __ATOMIC_RELAXED, __HIP_MEMORY_SCOPE_AGENT); }
__device__ __forceinline__ unsigned xb_add(unsigned* p, unsigned v) { return __hip_atomic_fetch_add(p, v, __ATOMIC_RELAXED, __HIP_MEMORY_SCOPE_AGENT); }
__device__ __forceinline__ unsigned xb_xcc_id() { return (unsigned)__builtin_amdgcn_s_getreg((3 << 11) | 20) & 0xFu; }
#define XB_SPIN(cond, bar) do { unsigned _sp = 0; while (cond) { __builtin_amdgcn_s_sleep(1); \
    if ((++_sp & 255u) == 0u) { if (xb_ld(&(bar)[XB_TMO])) break; if (_sp > XB_SPIN_CAP) { atomicAdd(&(bar)[XB_TMO], 1u); break; } } } } while (0)
__device__ __forceinline__ void xcd_barrier_complete(unsigned* bar, unsigned x, unsigned& nloc, unsigned& nx) {
  const unsigned G = gridDim.x * gridDim.y * gridDim.z;
  unsigned sum, cnt, mine, sp = 0u;
  for (;;) {
    sum = 0u; cnt = 0u; mine = 0u;
    #pragma unroll
    for (unsigned j = 0; j < 16; ++j) { const unsigned c = xb_ld(&bar[XB_XCNT(j)]); sum += c; cnt += (c > 0u) ? 1u : 0u; mine = (j == x) ? c : mine; }
    if (sum == G) break;
    __builtin_amdgcn_s_sleep(1);
    if ((++sp & 255u) == 0u) { if (xb_ld(&bar[XB_TMO])) break; if (sp > XB_SPIN_CAP) { atomicAdd(&bar[XB_TMO], 1u); break; } }
  }
  nloc = mine > 0u ? mine : 1u; nx = cnt > 0u ? cnt : 1u;
}
__device__ __forceinline__ void xcd_barrier(unsigned* bar, volatile LAS unsigned* st) {
  asm volatile("s_waitcnt vmcnt(0) lgkmcnt(0)" ::: "memory");
  __syncthreads();
  if (threadIdx.x == 0) {
    const unsigned x = xb_xcc_id();
    unsigned nloc = st[0], nx = st[1];
    if (nloc == 0u) { xcd_barrier_complete(bar, x, nloc, nx); st[0] = nloc; st[1] = nx; }
    const unsigned old = xb_add(&bar[XB_XSUB(x)], 1u);
    const unsigned gen = old / nloc;
    if (old + 1u == (gen + 1u) * nloc) {
      __builtin_amdgcn_fence(__ATOMIC_RELEASE, "agent");
      asm volatile("s_waitcnt vmcnt(0)" ::: "memory");
      const unsigned og = xb_add(&bar[XB_TOP], 1u);
      const unsigned tg = og / nx;
      if (og + 1u == (tg + 1u) * nx) xb_add(&bar[XB_TOPGEN], 1u);
      else XB_SPIN(xb_ld(&bar[XB_TOPGEN]) == tg, bar);
      __builtin_amdgcn_fence(__ATOMIC_ACQUIRE, "agent");
      xb_add(&bar[XB_XGEN(x)], 1u);
      asm volatile("s_waitcnt vmcnt(0)" ::: "memory");
    } else {
      XB_SPIN(xb_ld(&bar[XB_XGEN(x)]) == gen, bar);
      __builtin_amdgcn_fence(__ATOMIC_ACQUIRE, "agent");
      asm volatile("s_waitcnt vmcnt(0)" ::: "memory");
    }
  }
  __syncthreads();
}

constexpr int N_PHASES = 50;
__device__ __forceinline__ void run_phase(const Params& p, int ph, char* lds) {
  if (ph == 0) { phase_prep(p, lds);
#ifdef REP_PREP
    phase_prep(p, lds);
#endif
    return; }
  if (ph == N_PHASES - 1) { phase_final(p); return; }
  const int l = (ph - 1) / 24, q = (ph - 1) % 24;
  if (q == 0) phase_norm(p, l, 0);
  else if (q == 1) { for (int rep = 0; rep < REP_GEMM; ++rep) phase_ffn_up(p, l, 0, lds); }
  else if (q == 2) phase_ffn_down(p, l, 0, lds);
  else if (q == 3) phase_norm(p, l, 1);
  else if (q < 21) { const int g = (q - 4) >> 2, s = (q - 4) & 3;
    if (s == 0) { if (g > 0) phase_wout(p, l, g - 1, lds);
      if (g < 4) { for (int rep = 0; rep < REP_GEMM; ++rep) phase_win(p, l, g, lds); } }
    else if (s == 1) { for (int rep = 0; rep < REP_GEMM; ++rep) phase_up(p, l, g, lds); }
    else if (s == 2) phase_mix(p, l, g, lds);
    else { for (int rep = 0; rep < REP_GEMM; ++rep) phase_merge(p, l, g, lds); }
  }
  else if (q == 21) phase_norm(p, l, 2);
  else if (q == 22) { for (int rep = 0; rep < REP_GEMM; ++rep) phase_ffn_up(p, l, 1, lds); }
  else phase_ffn_down(p, l, 1, lds);
}

__global__ void __launch_bounds__(NTHR, 2) mega(Params p) {
  extern __shared__ __attribute__((aligned(16))) char lds[];
#if MK_COOP
  cg::grid_group grid = cg::this_grid();
#endif
#if MK_COOP
  volatile LAS unsigned* xst = (volatile LAS unsigned*)((LAS unsigned char*)lds + LDS_SPARE);
  unsigned* xbar = (unsigned*)(p.ws + WS_XBAR);
  if (blockIdx.x == 0) for (int i = threadIdx.x; i < XCD_BAR_WORDS; i += NTHR) __hip_atomic_store(xbar + i, 0u, __ATOMIC_RELAXED, __HIP_MEMORY_SCOPE_AGENT);
  if (threadIdx.x < 2) xst[threadIdx.x] = 0u;
  grid.sync();
  if (threadIdx.x == 0) (void)xb_add(&xbar[XB_XCNT(xb_xcc_id())], 1u);
#endif
  for (int ph = p.ph_lo; ph < p.ph_hi; ++ph) {
    Params q = p;
    { __attribute__((address_space(1))) unsigned char* gws = (__attribute__((address_space(1))) unsigned char*)q.ws;
      __attribute__((address_space(1))) float* gout = (__attribute__((address_space(1))) float*)q.out;
      asm volatile("" : "+s"(gws), "+s"(gout));
      q.ws = (unsigned char*)gws; q.out = (float*)gout; }
    run_phase(q, ph, lds);
#if MK_COOP
    if (ph + 1 < p.ph_hi) xcd_barrier((unsigned*)(p.ws + WS_XBAR), (volatile LAS unsigned*)((LAS unsigned char*)lds + LDS_SPARE));
#endif
  }
}

extern "C" void kernel_launch(void* const* d_in, const int* in_sizes, int n_in, void* d_out, int out_size, void* d_ws, size_t ws_size, hipStream_t stream) {
  static int grid_blocks = 0;
  if (!grid_blocks) {
    int dev = 0, cus = 0, per_cu = 0;
    (void)hipGetDevice(&dev);
    (void)hipDeviceGetAttribute(&cus, hipDeviceAttributeMultiprocessorCount, dev);
    (void)hipFuncSetAttribute((const void*)mega, hipFuncAttributeMaxDynamicSharedMemorySize, LDS_BYTES);
    (void)hipOccupancyMaxActiveBlocksPerMultiprocessor(&per_cu, (const void*)mega, NTHR, LDS_BYTES);
    if (per_cu < 1) per_cu = 1;
    grid_blocks = cus * per_cu;
    if (ws_size < WS_END) fprintf(stderr, "kernel_launch: workspace too small: %zu < %zu\n", ws_size, (size_t)WS_END);
  }
  if (n_in < 31 || ws_size < WS_END) return;
  Params p{};
  for (int i = 0; i < 31; ++i) p.in[i] = (const float*)d_in[i];
  p.out = (float*)d_out; p.ws = (unsigned char*)d_ws;
#if MK_COOP
  (void)hipMemsetAsync((unsigned char*)d_ws + WS_BAR, 0, 256 + 16384, stream);
  p.ph_lo = 0; p.ph_hi = N_PHASES;
  void* args[] = {&p};
  hipError_t e = hipLaunchCooperativeKernel((void*)mega, dim3(grid_blocks), dim3(NTHR), args, LDS_BYTES, stream);
  if (e != hipSuccess) fprintf(stderr, "cooperative launch failed: %s (grid %d)\n", hipGetErrorString(e), grid_blocks);
#else
  for (int ph = 0; ph < N_PHASES; ++ph) { p.ph_lo = ph; p.ph_hi = ph + 1;
    hipLaunchKernelGGL(mega, dim3(grid_blocks), dim3(NTHR), LDS_BYTES, stream, p); }
#endif
}
```

```cpp
#include <hip/hip_runtime.h>
#include <hip/hip_bf16.h>
#include <hip/hip_cooperative_groups.h>
#include <cstdio>
#include <cstdint>
namespace cg = cooperative_groups;

#ifndef REP_GEMM
#define REP_GEMM 1
#endif
#ifndef REP_MLA
#define REP_MLA 1
#endif
#ifndef MK_COOP
#define MK_COOP 1
#endif

using bf16 = __hip_bfloat16;
typedef unsigned short u16;
using bf16x8 = __attribute__((ext_vector_type(8))) short;
using s16x4  = __attribute__((ext_vector_type(4))) short;
using f32x4  = __attribute__((ext_vector_type(4))) float;
using f32x16 = __attribute__((ext_vector_type(16))) float;
using u32x4  = __attribute__((ext_vector_type(4))) unsigned;
using u32x2  = __attribute__((ext_vector_type(2))) unsigned;

constexpr int DM = 1024, NB = 8, SEQ = 4096, CTXL = 256, DFF = 2816, NMOD = 9;
constexpr int R_ALL = 34816;
constexpr int GR = 8704, NGRP = 4, GLAT = 8192;
constexpr int NWIN = 8992, NWINP = 9216;
constexpr float EPS = 1e-6f;
constexpr int NTHR = 512;
constexpr int LDS_BYTES = 136 * 1024;
constexpr int LDS_SPARE = 128 * 1024;

enum { I_X = 0, I_C, I_CTX, I_CCTX, I_ADAW, I_ADAB, I_NFFN1, I_F1W13, I_F1W2, I_NMIX, I_WIN, I_BGATE, I_LNVG, I_LNVB, I_SPW, I_SPB,
       I_LQ1, I_LK1, I_LQ2, I_LK2, I_SUBLN, I_QNG, I_WUQ, I_KVNG, I_WUKV, I_WBR, I_WOUT, I_NFFN2, I_F2W13, I_F2W2, I_NFINAL };

constexpr size_t al256(size_t x) { return (x + 255) / 256 * 256; }
constexpr size_t WS_CTXRES = 0;
constexpr size_t WS_MOD   = WS_CTXRES + (size_t)2048 * 1024 * 4;
constexpr size_t WS_COSB  = WS_MOD + al256((size_t)2 * 9 * 9216 * 4);
constexpr size_t WS_SINB  = WS_COSB + (size_t)4096 * 32 * 4;
constexpr size_t WS_COSC  = WS_SINB + (size_t)4096 * 32 * 4;
constexpr size_t WS_SINC  = WS_COSC + (size_t)4096 * 16 * 4;
constexpr size_t WS_LAM   = WS_SINC + (size_t)4096 * 16 * 4;
constexpr size_t WS_BAR   = WS_LAM + 256;
constexpr size_t WS_XBAR  = WS_BAR + 256;
constexpr size_t WS_W     = WS_XBAR + 16384;
constexpr size_t WO_W13A = 0;
constexpr size_t WO_W2A  = WO_W13A + (size_t)5632 * 1024 * 2;
constexpr size_t WO_W13B = WO_W2A + (size_t)1024 * 2816 * 2;
constexpr size_t WO_W2B  = WO_W13B + (size_t)5632 * 1024 * 2;
constexpr size_t WO_WIN  = WO_W2B + (size_t)1024 * 2816 * 2;
constexpr size_t WO_WUQ  = WO_WIN + (size_t)NWINP * 1024 * 2;
constexpr size_t WO_WUKV = WO_WUQ + (size_t)1536 * 512 * 2;
constexpr size_t WO_WBR  = WO_WUKV + (size_t)2048 * 256 * 2;
constexpr size_t WO_WOUT = WO_WBR + (size_t)3 * 1024 * 1024 * 2;
constexpr size_t W_LAYER = WO_WOUT + (size_t)1024 * 1024 * 2;
constexpr size_t WS_H    = WS_W + 2 * W_LAYER;
constexpr size_t WS_BIG  = WS_H + (size_t)R_ALL * 1024 * 2;
constexpr size_t WS_ACT  = WS_BIG;
constexpr size_t WS_GA   = WS_BIG;
constexpr size_t WS_QB   = WS_GA + (size_t)GR * 2048 * 2;
constexpr size_t WS_KB   = WS_QB + (size_t)GR * 1024 * 2;
constexpr size_t WS_VB   = WS_KB + (size_t)GR * 1024 * 2;
constexpr size_t WS_CQ   = WS_VB + (size_t)GR * 1024 * 2;
constexpr size_t WS_CKV  = WS_CQ + (size_t)GR * 512 * 2;
constexpr size_t WS_KR   = WS_CKV + (size_t)GR * 256 * 2;
constexpr size_t WS_GATES= WS_KR + (size_t)GR * 32 * 2;
constexpr size_t WS_QC   = WS_GATES + (size_t)GR * 3072 * 2;
constexpr size_t WS_KVC  = WS_QC + (size_t)GR * 1536 * 2;
constexpr size_t WS_OC   = WS_KVC + (size_t)GR * 2048 * 2;
constexpr size_t WS_YTMP = WS_OC + (size_t)GR * 1024 * 2;
constexpr size_t WS_SSQ  = WS_YTMP + (size_t)GR * 1024 * 4;
constexpr size_t WS_SSKV = WS_SSQ + (size_t)GR * 16 * 4;
constexpr size_t WS_MIXEND = WS_SSKV + (size_t)GR * 8 * 4;
constexpr size_t WS_Y    = WS_KVC;
constexpr size_t WS_FFNEND = WS_ACT + (size_t)R_ALL * DFF * 2;
constexpr size_t WS_END  = WS_MIXEND > WS_FFNEND ? WS_MIXEND : WS_FFNEND;

struct Params { const float* in[31]; float* out; unsigned char* ws; int ph_lo, ph_hi; };

__device__ __forceinline__ unsigned cvtpk(float lo, float hi) {
  unsigned r; asm volatile("v_cvt_pk_bf16_f32 %0, %1, %2" : "=v"(r) : "v"(lo), "v"(hi)); return r;
}
__device__ __forceinline__ unsigned cvtpk_s(float lo, float hi) {
  unsigned r; asm volatile("s_nop 1\n\tv_cvt_pk_bf16_f32 %0, %1, %2" : "=v"(r) : "v"(lo), "v"(hi)); return r;
}
__device__ __forceinline__ u16 f2bf(float x) { return (u16)(cvtpk_s(x, 0.f) & 0xffffu); }
__device__ __forceinline__ float bf2f(u16 u) { return __uint_as_float(((unsigned)u) << 16); }
__device__ __forceinline__ float bflo(unsigned w) { return __uint_as_float(w << 16); }
__device__ __forceinline__ float bfhi(unsigned w) { return __uint_as_float(w & 0xffff0000u); }
__device__ __forceinline__ float sigmoidf_(float x) { return __builtin_amdgcn_rcpf(1.f + __expf(-x)); }
__device__ __forceinline__ float siluf_(float x) { return x * __builtin_amdgcn_rcpf(1.f + __expf(-x)); }
__device__ __forceinline__ float gelu_tanh(float x) {
  float u = 0.7978845608028654f * (x + 0.044715f * x * x * x);
  float t = 1.f - 2.f * __builtin_amdgcn_rcpf(1.f + __expf(2.f * u));
  return 0.5f * x * (1.f + t);
}

__device__ __forceinline__ int obx() { int t = __builtin_amdgcn_workgroup_id_x(); asm volatile("" : "+s"(t)); return t; }
__device__ __forceinline__ int ogx() { int t = __builtin_amdgcn_grid_size_x() / NTHR; asm volatile("" : "+s"(t)); return t; }
__device__ __forceinline__ int otid() { int t = threadIdx.x; asm volatile("" : "+v"(t)); return t; }
__device__ __forceinline__ float shx(float v, int m) { const int l = otid(); return __int_as_float(__builtin_amdgcn_ds_bpermute(((l ^ m) & 63) << 2, __float_as_int(v))); }
#define DPP_ADD(v, CTRL) ((v) + __int_as_float(__builtin_amdgcn_mov_dpp(__float_as_int(v), CTRL, 0xF, 0xF, true)))
__device__ __forceinline__ float wave_sum(float v) {
  v = DPP_ADD(v, 0xB1); v = DPP_ADD(v, 0x4E); v = DPP_ADD(v, 0x141); v = DPP_ADD(v, 0x140);
  v += shx(v, 16); v += shx(v, 32); return v;
}
struct TileInfo { float* resid; int mi; int t0; bool lat; };
__device__ __forceinline__ TileInfo tile_info(int r, float* out, float* ctxres) {
  TileInfo ti; int g = r / GR; int rr = r - g * GR;
  if (rr < GLAT) { ti.resid = out + (size_t)(g * GLAT + rr) * DM; ti.mi = g * 2 + (rr >> 12); ti.t0 = rr & 4095; ti.lat = true; }
  else { int cr = rr - GLAT; ti.resid = ctxres + (size_t)(g * 512 + cr) * DM; ti.mi = 8; ti.t0 = 0; ti.lat = false; }
  return ti;
}

constexpr int BM = 256, BK = 64, HALF = 128, NXCD = 8, WGM = 8, HT = HALF * BK;
__device__ __forceinline__ int lds_byte(int r, int c) {
  int st = (r >> 4) * 2 + (c >> 5), rr = r & 15, cc = c & 31, ob = rr * 64 + cc * 2;
  return st * 1024 + (ob ^ (((ob >> 9) & 1) << 5));
}
__device__ __forceinline__ void stage_rc(int b, int& R, int& C) {
  int st = b / 1024, sb = b % 1024, swz = sb ^ (((sb >> 9) & 1) << 5);
  R = (st >> 1) * 16 + swz / 64; C = (st & 1) * 32 + (swz % 64) / 2;
}
__device__ __forceinline__ void tile_of(int L, int nM, int nN, int& pm, int& pn) {
  int nwg = nM * nN, wgid = L;
  { int q = nwg / NXCD, r = nwg % NXCD, xcd = wgid % NXCD, off = wgid / NXCD; wgid = (xcd < r ? xcd * (q + 1) : r * (q + 1) + (xcd - r) * q) + off; }
  int nig = WGM * nN, gid = wgid / nig, fm = gid * WGM, gsz = min(nM - fm, WGM);
  pm = fm + ((wgid % nig) % gsz); pn = (wgid % nig) / gsz;
}

typedef f32x4 Acc[2][2][4][2];
#define LAS __attribute__((address_space(3)))
constexpr int HTB = HALF * BK * 2;
struct Unit { const char* A; const char* B; int pm, pn, tag; };

struct GridSched {
  const char* A; const char* B; int nM, nN, G, c; size_t tstep; int xcd; int latonly;
  __device__ __forceinline__ bool next(int i, Unit& u) const {
    const int L = i * G + c; if (L >= nM * nN) return false;
    int pm, pn; if (xcd == 1) tile_of(L, nM, nN, pm, pn); else if (xcd == 2) { const int x = L & 7, jj = L >> 3; pn = x & 3; pm = 2 * jj + (x >> 2); } else { pm = L % nM; pn = L / nM; }
    if (latonly) pm = (pm >> 5) * 34 + (pm & 31);
    u.pm = pm; u.pn = pn; u.tag = 0; u.A = A + (size_t)pm * tstep; u.B = B + (size_t)pn * tstep; return true;
  }
};
struct MergeSched {
  const char* A0; const char* A1; const char* A2; const char* B; int nM, nN, G, c;
  __device__ __forceinline__ bool next(int i, Unit& u) const {
    const int t = i / 3, br = i - t * 3; const int L = t * G + c; if (L >= nM * nN) return false;
    const int x = L & 7, jj = L >> 3; const int pn = x & 3, pm = 2 * jj + (x >> 2);
    const size_t tstep = (size_t)256 * 1024 * 2;
    u.pm = pm; u.pn = pn; u.tag = br; u.A = (br == 0 ? A0 : (br == 1 ? A1 : A2)) + (size_t)pm * tstep; u.B = B + (size_t)br * 1024 * 1024 * 2 + (size_t)pn * tstep; return true;
  }
};

template <class Epi, class Sched, bool CARRY = false>
__device__ __forceinline__ void gemm_phase(LAS unsigned char* lds, const int K, const Sched& S, const Epi& E) {
  const int tid = otid(), wid = __builtin_amdgcn_readfirstlane(tid >> 6), lane = tid & 63, wr = wid >> 2, wc = wid & 3, fr = lane & 15, fq = lane >> 4;
  const int nt = K / BK;
  unsigned voff[2];
  #pragma unroll
  for (int i = 0; i < 2; ++i) { int R, C; stage_rc(tid * 16 + i * 8192, R, C); voff[i] = (unsigned)(R * K + C) * 2u; }
  const size_t kstep = (size_t)(BK * 2);
  const size_t hstep = (size_t)HALF * K * 2;
  const unsigned ldsw = (unsigned)wid * 1024u;
  const int aoff = lds_byte(wr * 64 + fr, fq * 8), boff = lds_byte(wc * 32 + fr, fq * 8);
#define PG8_SA(b, h) (((b) * 2 + (h)) * HTB)
#define PG8_SB(b, h) ((4 + (b) * 2 + (h)) * HTB)
#define PG8_STAGE(bufoff, gbase) do { _Pragma("unroll") for (int _i = 0; _i < 2; ++_i) \
    __builtin_amdgcn_global_load_lds((const unsigned*)((const char*)(gbase) + voff[_i]), (LAS unsigned*)(lds + (bufoff) + ldsw + _i * 8192), 16, 0, 0); } while (0)
#define PG8_LDA(dst, b, h) do { _Pragma("unroll") for (int m = 0; m < 4; ++m) _Pragma("unroll") for (int k = 0; k < 2; ++k) dst[m][k] = *(const LAS bf16x8*)(lds + PG8_SA(b, h) + aoff + m * 2048 + k * 1024); } while (0)
#define PG8_LDB(dst, b, h) do { _Pragma("unroll") for (int n = 0; n < 2; ++n) _Pragma("unroll") for (int k = 0; k < 2; ++k) dst[n][k] = *(const LAS bf16x8*)(lds + PG8_SB(b, h) + boff + n * 2048 + k * 1024); } while (0)
#define PG8_MMA(ai, bj, At, Bt) do { __builtin_amdgcn_s_setprio(1); _Pragma("unroll") for (int m = 0; m < 4; ++m) _Pragma("unroll") for (int n = 0; n < 2; ++n) _Pragma("unroll") for (int k = 0; k < 2; ++k) \
    acc[ai][bj][m][n] = __builtin_amdgcn_mfma_f32_16x16x32_bf16(Bt[n][k], At[m][k], acc[ai][bj][m][n], 0, 0, 0); __builtin_amdgcn_s_setprio(0); } while (0)
#define PG8_WAIT_V(n) asm volatile("s_waitcnt vmcnt(" #n ")" ::: "memory")
#define PG8_WAIT_L(n) asm volatile("s_waitcnt lgkmcnt(" #n ")" ::: "memory")
#define PG8_BAR __builtin_amdgcn_s_barrier()
#define PG8_SCHED __builtin_amdgcn_sched_barrier(0)
  Unit cur, nxt; int ui = 0;
  if (!S.next(0, cur)) return;
  f32x4 acc[2][2][4][2];
  float zz = 0.f; asm volatile("" : "+v"(zz));
  #pragma unroll
  for (int a = 0; a < 2; ++a)
  #pragma unroll
  for (int b = 0; b < 2; ++b)
  #pragma unroll
  for (int m = 0; m < 4; ++m)
  #pragma unroll
  for (int n = 0; n < 2; ++n) acc[a][b][m][n] = (f32x4){zz, zz, zz, zz};
  bf16x8 At[4][2], B0[2][2], B1[2][2];
  const char* cA = cur.A; const char* cB = cur.B;
  __builtin_amdgcn_s_waitcnt(0x0F70);
  PG8_STAGE(PG8_SB(0, 0), cB); PG8_STAGE(PG8_SA(0, 0), cA); PG8_STAGE(PG8_SB(0, 1), cB + hstep); PG8_STAGE(PG8_SA(0, 1), cA + hstep);
  if (wr == 1) PG8_BAR;
  PG8_WAIT_V(4); PG8_BAR;
  PG8_STAGE(PG8_SB(1, 0), cB + kstep); PG8_STAGE(PG8_SA(1, 0), cA + kstep); PG8_STAGE(PG8_SB(1, 1), cB + hstep + kstep);
  PG8_WAIT_V(6); PG8_BAR;
  for (;;) {
    const bool has_next = S.next(ui + 1, nxt);
    const char* nA = has_next ? nxt.A : cA; const char* nB = has_next ? nxt.B : cB;
    for (int t = 0; t < nt; t += 2) {
      const bool last = (t == nt - 2);
      const char* a1 = cA + (size_t)(t + 1) * kstep;
      const char* a2 = last ? nA : cA + (size_t)(t + 2) * kstep; const char* b2 = last ? nB : cB + (size_t)(t + 2) * kstep;
      const char* a3 = a2 + kstep; const char* b3 = b2 + kstep;
      PG8_LDB(B0, 0, 0); PG8_SCHED; PG8_LDA(At, 0, 0); PG8_STAGE(PG8_SA(1, 1), a1 + hstep);
      PG8_WAIT_L(8); PG8_BAR; PG8_WAIT_L(0); PG8_MMA(0, 0, At, B0); PG8_BAR; PG8_SCHED;
      PG8_LDB(B1, 0, 1); PG8_STAGE(PG8_SB(0, 0), b2);
      PG8_BAR; PG8_WAIT_L(0); PG8_MMA(0, 1, At, B1); PG8_BAR;
      PG8_LDA(At, 0, 1); PG8_STAGE(PG8_SA(0, 0), a2);
      PG8_BAR; PG8_WAIT_L(0); PG8_MMA(1, 0, At, B0); PG8_BAR; PG8_SCHED;
      PG8_STAGE(PG8_SB(0, 1), b2 + hstep);
      PG8_WAIT_V(6); PG8_BAR; PG8_MMA(1, 1, At, B1); PG8_BAR;
      PG8_LDB(B0, 1, 0); PG8_SCHED; PG8_LDA(At, 1, 0); PG8_STAGE(PG8_SA(0, 1), a2 + hstep);
      PG8_WAIT_L(8); PG8_BAR; PG8_WAIT_L(0); PG8_MMA(0, 0, At, B0); PG8_BAR; PG8_SCHED;
      PG8_LDB(B1, 1, 1); PG8_STAGE(PG8_SB(1, 0), b3);
      PG8_BAR; PG8_WAIT_L(0); PG8_MMA(0, 1, At, B1); PG8_BAR;
      PG8_LDA(At, 1, 1); PG8_STAGE(PG8_SA(1, 0), a3);
      PG8_BAR; PG8_WAIT_L(0); PG8_MMA(1, 0, At, B0); PG8_BAR; PG8_SCHED;
      PG8_STAGE(PG8_SB(1, 1), b3 + hstep);
      PG8_WAIT_V(6); PG8_BAR; PG8_MMA(1, 1, At, B1); PG8_BAR;
    }
    { const int t2 = otid(), l2 = t2 & 63; E.apply(acc, cur, wr, wc, l2 & 15, l2 >> 4); }
    if (!has_next) break;
    __builtin_amdgcn_s_waitcnt(0x0F70);
    if (!(CARRY && cur.tag < 2)) {
      #pragma unroll
      for (int a = 0; a < 2; ++a)
      #pragma unroll
      for (int b = 0; b < 2; ++b)
      #pragma unroll
      for (int m = 0; m < 4; ++m)
      #pragma unroll
      for (int n = 0; n < 2; ++n) acc[a][b][m][n] = (f32x4){zz, zz, zz, zz};
    }
    cur = nxt; cA = nA; cB = nB; ++ui;
  }
  PG8_WAIT_V(0);
  if (wr == 0) PG8_BAR;
  PG8_BAR;
#undef PG8_SA
#undef PG8_SB
#undef PG8_STAGE
#undef PG8_LDA
#undef PG8_LDB
#undef PG8_MMA
#undef PG8_WAIT_V
#undef PG8_WAIT_L
#undef PG8_BAR
#undef PG8_SCHED
}

__device__ __forceinline__ void st4bf(bf16* p, f32x4 v) {
  u32x2 w = {cvtpk_s(v[0], v[1]), cvtpk_s(v[2], v[3])}; *reinterpret_cast<u32x2*>(p) = w;
}

struct EpiSwiglu {
  bf16* act;
  __device__ __forceinline__ void apply(Acc& acc, const Unit& u, int wr, int wc, int fr, int fq) const {
    const int brow = u.pm * 256, bcol = u.pn * 256;
    const int cb = (bcol >> 1) + wc * 32 + fq * 4;
    #pragma unroll
    for (int ai = 0; ai < 2; ++ai)
    #pragma unroll
    for (int m = 0; m < 4; ++m) {
      const size_t row = brow + ai * 128 + wr * 64 + m * 16 + fr;
      #pragma unroll
      for (int n = 0; n < 2; ++n) {
        f32x4 a = acc[ai][0][m][n], b = acc[ai][1][m][n], v;
        #pragma unroll
        for (int j = 0; j < 4; ++j) v[j] = siluf_(a[j]) * b[j];
        st4bf(act + row * DFF + cb + n * 16, v);
      }
    }
  }
};
struct EpiResid {
  float* out; float* ctxres; const float* gate; float coef; int row0; int dry; const float* src_lat; const float* src_ctx;
  __device__ __forceinline__ void apply(Acc& acc, const Unit& u, int wr, int wc, int fr, int fq) const {
    const int brow = u.pm * 256, bcol = u.pn * 256;
    TileInfo ti = tile_info(row0 + brow, out, ctxres);
    const float* srcb = tile_info(row0 + brow, const_cast<float*>(src_lat), const_cast<float*>(src_ctx)).resid;
    const float* g = gate + (size_t)ti.mi * 9216;
    #pragma unroll
    for (int bj = 0; bj < 2; ++bj)
    #pragma unroll
    for (int n = 0; n < 2; ++n) {
      const int col = bcol + bj * 128 + wc * 32 + n * 16 + fq * 4;
      f32x4 gv = *(const __attribute__((address_space(1))) f32x4*)(g + col);
      #pragma unroll
      for (int ai = 0; ai < 2; ++ai)
      #pragma unroll
      for (int m = 0; m < 4; ++m) {
        float* p = ti.resid + (size_t)(ai * 128 + wr * 64 + m * 16 + fr) * DM + col;
        f32x4 x = *(const __attribute__((address_space(1))) f32x4*)(srcb + (size_t)(ai * 128 + wr * 64 + m * 16 + fr) * DM + col);
        #pragma unroll
        for (int j = 0; j < 4; ++j) x[j] += coef * gv[j] * acc[ai][bj][m][n][j];
        if (!dry) *(__attribute__((address_space(1))) f32x4*)(p) = x;
      }
    }
  }
};
struct EpiWin {
  unsigned char* ws; const float* bgate; int row0;
  __device__ __forceinline__ void apply(Acc& acc, const Unit& u, int wr, int wc, int fr, int fq) const {
    const int brow = u.pm * 256, bcol = u.pn * 256;
    TileInfo ti = tile_info(row0 + brow, nullptr, nullptr);
    const float* cosb = (const float*)(ws + WS_COSB); const float* sinb = (const float*)(ws + WS_SINB);
    const float* cosc = (const float*)(ws + WS_COSC); const float* sinc = (const float*)(ws + WS_SINC);
    #pragma unroll
    for (int bj = 0; bj < 2; ++bj) {
      const int c0 = bcol + bj * 128 + wc * 32;
      if (c0 >= NWIN) continue;
      if (c0 < 2048) {
        bf16* ga = (bf16*)(ws + WS_GA);
        #pragma unroll
        for (int ai = 0; ai < 2; ++ai)
        #pragma unroll
        for (int m = 0; m < 4; ++m) {
          const size_t row = brow + ai * 128 + wr * 64 + m * 16 + fr;
          #pragma unroll
          for (int n = 0; n < 2; ++n) { f32x4 v;
            #pragma unroll
            for (int j = 0; j < 4; ++j) v[j] = gelu_tanh(acc[ai][bj][m][n][j]);
            st4bf(ga + row * 2048 + c0 + n * 16 + fq * 4, v); }
        }
      } else if (c0 < 4096) {
        bf16* dst = (bf16*)(ws + (c0 < 3072 ? WS_QB : WS_KB));
        const int cc = (c0 - (c0 < 3072 ? 2048 : 3072));
        const int f0 = ((c0 >> 5) & 1) * 16 + fq * 4;
        #pragma unroll
        for (int ai = 0; ai < 2; ++ai)
        #pragma unroll
        for (int m = 0; m < 4; ++m) {
          const int rl = ai * 128 + wr * 64 + m * 16 + fr;
          const size_t row = brow + rl;
          f32x4 x1 = acc[ai][bj][m][0], x2 = acc[ai][bj][m][1], y1, y2;
          if (ti.lat) {
            const int t = ti.t0 + rl;
            f32x4 cs = *reinterpret_cast<const f32x4*>(cosb + t * 32 + f0), sn = *reinterpret_cast<const f32x4*>(sinb + t * 32 + f0);
            #pragma unroll
            for (int j = 0; j < 4; ++j) { y1[j] = x1[j] * cs[j] - x2[j] * sn[j]; y2[j] = x2[j] * cs[j] + x1[j] * sn[j]; }
          } else { y1 = x1; y2 = x2; }
          st4bf(dst + row * 1024 + cc + fq * 4, y1); st4bf(dst + row * 1024 + cc + 16 + fq * 4, y2);
        }
      } else if (c0 < 5120) {
        bf16* dst = (bf16*)(ws + WS_VB);
        #pragma unroll
        for (int ai = 0; ai < 2; ++ai)
        #pragma unroll
        for (int m = 0; m < 4; ++m) {
          const size_t row = brow + ai * 128 + wr * 64 + m * 16 + fr;
          #pragma unroll
          for (int n = 0; n < 2; ++n) st4bf(dst + row * 1024 + (c0 - 4096) + n * 16 + fq * 4, acc[ai][bj][m][n]);
        }
      } else if (c0 < 5888) {
        const bool isq = c0 < 5632;
        bf16* dst = (bf16*)(ws + (isq ? WS_CQ : WS_CKV));
        float* ss = (float*)(ws + (isq ? WS_SSQ : WS_SSKV));
        const int cc = c0 - (isq ? 5120 : 5632), ld = isq ? 512 : 256, nch = isq ? 16 : 8;
        #pragma unroll
        for (int ai = 0; ai < 2; ++ai)
        #pragma unroll
        for (int m = 0; m < 4; ++m) {
          const size_t row = brow + ai * 128 + wr * 64 + m * 16 + fr;
          float s = 0.f;
          #pragma unroll
          for (int n = 0; n < 2; ++n) {
            f32x4 v = acc[ai][bj][m][n];
            #pragma unroll
            for (int j = 0; j < 4; ++j) s += v[j] * v[j];
            st4bf(dst + row * ld + cc + n * 16 + fq * 4, v);
          }
          s += shx(s, 16); s += shx(s, 32);
          if (fq == 0) ss[row * nch + (cc >> 5)] = s;
        }
      } else if (c0 < 5920) {
        bf16* dst = (bf16*)(ws + WS_KR);
        #pragma unroll
        for (int ai = 0; ai < 2; ++ai)
        #pragma unroll
        for (int m = 0; m < 4; ++m) {
          const int rl = ai * 128 + wr * 64 + m * 16 + fr;
          const size_t row = brow + rl;
          f32x4 x1 = acc[ai][bj][m][0], x2 = acc[ai][bj][m][1], y1, y2;
          if (ti.lat) {
            const int t = ti.t0 + rl;
            f32x4 cs = *reinterpret_cast<const f32x4*>(cosc + t * 16 + fq * 4), sn = *reinterpret_cast<const f32x4*>(sinc + t * 16 + fq * 4);
            #pragma unroll
            for (int j = 0; j < 4; ++j) { y1[j] = x1[j] * cs[j] - x2[j] * sn[j]; y2[j] = x2[j] * cs[j] + x1[j] * sn[j]; }
          } else { y1 = x1; y2 = x2; }
          st4bf(dst + row * 32 + fq * 4, y1); st4bf(dst + row * 32 + 16 + fq * 4, y2);
        }
      } else {
        bf16* dst = (bf16*)(ws + WS_GATES);
        const int cc = c0 - 5920;
        #pragma unroll
        for (int n = 0; n < 2; ++n) {
          f32x4 bg = *reinterpret_cast<const f32x4*>(bgate + cc + n * 16 + fq * 4);
          #pragma unroll
          for (int ai = 0; ai < 2; ++ai)
          #pragma unroll
          for (int m = 0; m < 4; ++m) {
            const size_t row = brow + ai * 128 + wr * 64 + m * 16 + fr; f32x4 v;
            #pragma unroll
            for (int j = 0; j < 4; ++j) v[j] = sigmoidf_(acc[ai][bj][m][n][j] + bg[j]);
            st4bf(dst + row * 3072 + cc + n * 16 + fq * 4, v);
          }
        }
      }
    }
  }
};
template <int isq> struct EpiUp {
  unsigned char* ws; int row0;
  __device__ __forceinline__ void apply(Acc& acc, const Unit& u, int wr, int wc, int fr, int fq) const {
    const int brow = u.pm * 256, bcol = u.pn * 256;
    TileInfo ti = tile_info(row0 + brow, nullptr, nullptr);
    const float* cosc = (const float*)(ws + WS_COSC); const float* sinc = (const float*)(ws + WS_SINC);
    bf16* dst = (bf16*)(ws + (isq ? WS_QC : WS_KVC)); const int ld = isq ? 1536 : 2048;
    float rinv[2][4];
    { f32x4 pv[2][4];
      #pragma unroll
      for (int ai = 0; ai < 2; ++ai)
      #pragma unroll
      for (int m = 0; m < 4; ++m) {
        const size_t row = brow + ai * 128 + wr * 64 + m * 16 + fr;
        if (isq) pv[ai][m] = reinterpret_cast<const f32x4*>((const float*)(ws + WS_SSQ) + row * 16)[fq];
        else pv[ai][m] = reinterpret_cast<const f32x4*>((const float*)(ws + WS_SSKV) + row * 8)[fq & 1];
      }
      #pragma unroll
      for (int ai = 0; ai < 2; ++ai)
      #pragma unroll
      for (int m = 0; m < 4; ++m) {
        float sm = pv[ai][m][0] + pv[ai][m][1] + pv[ai][m][2] + pv[ai][m][3];
        if (!isq && fq >= 2) sm = 0.f;
        sm += shx(sm, 16); sm += shx(sm, 32);
        rinv[ai][m] = rsqrtf(sm * (isq ? 1.f / 512.f : 1.f / 256.f) + EPS);
      } }
    #pragma unroll
    for (int ai = 0; ai < 2; ++ai)
    #pragma unroll
    for (int m = 0; m < 4; ++m) {
      const int rl = ai * 128 + wr * 64 + m * 16 + fr;
      const size_t row = brow + rl; const float ri = rinv[ai][m];
      #pragma unroll
      for (int bj = 0; bj < 2; ++bj) {
        const int c0 = bcol + bj * 128 + wc * 32;
        const bool rope = isq && ((c0 >> 5) % 3 == 2) && ti.lat;
        f32x4 x1 = acc[ai][bj][m][0], x2 = acc[ai][bj][m][1], y1, y2;
        #pragma unroll
        for (int j = 0; j < 4; ++j) { x1[j] *= ri; x2[j] *= ri; }
        if (rope) {
          const int t = ti.t0 + rl;
          f32x4 cs = *reinterpret_cast<const f32x4*>(cosc + t * 16 + fq * 4), sn = *reinterpret_cast<const f32x4*>(sinc + t * 16 + fq * 4);
          #pragma unroll
          for (int j = 0; j < 4; ++j) { y1[j] = x1[j] * cs[j] - x2[j] * sn[j]; y2[j] = x2[j] * cs[j] + x1[j] * sn[j]; }
        } else { y1 = x1; y2 = x2; }
        st4bf(dst + row * ld + c0 + fq * 4, y1); st4bf(dst + row * ld + c0 + 16 + fq * 4, y2);
      }
    }
  }
};
struct EpiMerge {
  unsigned char* ws;
  __device__ __forceinline__ void apply(Acc& acc, const Unit& u, int wr, int wc, int fr, int fq) const {
    const int brow = u.pm * 256, bcol = u.pn * 256;
    const int br = u.tag;
    const bf16* gates = (const bf16*)(ws + WS_GATES); bf16* y = (bf16*)(ws + WS_Y);
    #pragma unroll
    for (int bj = 0; bj < 2; ++bj)
    #pragma unroll
    for (int n = 0; n < 2; ++n) {
      const int col = bcol + bj * 128 + wc * 32 + n * 16 + fq * 4;
      #pragma unroll
      for (int ai = 0; ai < 2; ++ai)
      #pragma unroll
      for (int m = 0; m < 4; ++m) {
        const size_t row = brow + ai * 128 + wr * 64 + m * 16 + fr;
        const u32x2 gw = *reinterpret_cast<const u32x2*>(gates + row * 3072 + br * 1024 + col);
        f32x4 a = acc[ai][bj][m][n], v;
        v[0] = fmaxf(bflo(gw[0]), 1e-10f) * a[0]; v[1] = fmaxf(bfhi(gw[0]), 1e-10f) * a[1]; v[2] = fmaxf(bflo(gw[1]), 1e-10f) * a[2]; v[3] = fmaxf(bfhi(gw[1]), 1e-10f) * a[3];
        if (br < 2) {
          const u32x2 gn = *reinterpret_cast<const u32x2*>(gates + row * 3072 + (br + 1) * 1024 + col);
          v[0] *= __builtin_amdgcn_rcpf(fmaxf(bflo(gn[0]), 1e-10f)); v[1] *= __builtin_amdgcn_rcpf(fmaxf(bfhi(gn[0]), 1e-10f));
          v[2] *= __builtin_amdgcn_rcpf(fmaxf(bflo(gn[1]), 1e-10f)); v[3] *= __builtin_amdgcn_rcpf(fmaxf(bfhi(gn[1]), 1e-10f));
          acc[ai][bj][m][n] = v;
        } else st4bf(y + row * 1024 + col, v);
      }
    }
  }
};

#define KSWZ(row, colB) ((row) * 256 + ((colB) ^ (((row) & 7) << 4)))
#define SBAR() __builtin_amdgcn_sched_barrier(0)
constexpr int KVBLK = 64;
constexpr int SHM_V = KVBLK * 128 * 2, SHM_K = KVBLK * 128 * 2;
constexpr float ATT_THR = 8.f;
__device__ __forceinline__ int crow(int r, int hi) { return (r & 3) + 8 * (r >> 2) + 4 * hi; }

template <int MODE> struct ACfg;
template <> struct ACfg<0> { static constexpr int ND0 = 4, NDV = 4; static constexpr float SCALE = 0.125f; };
template <> struct ACfg<1> { static constexpr int ND0 = 6, NDV = 2; static constexpr float SCALE = 0.10206207261596575f; };

template <int MODE>
__device__ __forceinline__ void partialSM(f32x16& p0, f32x16& p1, float& m_reg, float& mn, float& alpha) {
  constexpr float SC = ACfg<MODE>::SCALE;
  constexpr float C = SC * 1.4426950408889634f;
  float pmax = p0[0];
  #pragma unroll
  for (int r = 1; r < 16; ++r) pmax = fmaxf(pmax, p0[r]);
  #pragma unroll
  for (int r = 0; r < 16; ++r) pmax = fmaxf(pmax, p1[r]);
  { auto rr = __builtin_amdgcn_permlane32_swap(__float_as_uint(pmax), __float_as_uint(pmax), false, false);
    pmax = fmaxf(__uint_as_float(rr[0]), __uint_as_float(rr[1])); }
  if (__builtin_expect(__all(pmax - m_reg <= ATT_THR / SC), 1)) { mn = m_reg; alpha = 1.f; }
  else { mn = fmaxf(m_reg, pmax); alpha = __builtin_amdgcn_exp2f((m_reg - mn) * C); m_reg = mn; }
  float mnC = -mn * C;
  #pragma unroll
  for (int r = 0; r < 16; ++r) p0[r] = fmaf(p0[r], C, mnC);
  #pragma unroll
  for (int r = 0; r < 16; ++r) p1[r] = fmaf(p1[r], C, mnC);
  #pragma unroll
  for (int r = 0; r < 16; ++r) p0[r] = __builtin_amdgcn_exp2f(p0[r]);
}
template <bool SUM>
__device__ __forceinline__ void finishSM(f32x16& p0, f32x16& p1, float alpha, float& l_reg, bf16x8& pa0, bf16x8& pa1, bf16x8& pa2, bf16x8& pa3) {
  #pragma unroll
  for (int r = 0; r < 16; ++r) p1[r] = __builtin_amdgcn_exp2f(p1[r]);
  if constexpr (SUM) {
    float ps = 0;
    #pragma unroll
    for (int r = 0; r < 16; ++r) ps += p0[r];
    #pragma unroll
    for (int r = 0; r < 16; ++r) ps += p1[r];
    { auto rr = __builtin_amdgcn_permlane32_swap(__float_as_uint(ps), __float_as_uint(ps), false, false);
      ps = __uint_as_float(rr[0]) + __uint_as_float(rr[1]); }
    l_reg = l_reg * alpha + ps;
  }
#define PK4(P, BASE, OUT) do { unsigned a0 = cvtpk(P[BASE + 0], P[BASE + 1]), a1 = cvtpk(P[BASE + 2], P[BASE + 3]);   \
    unsigned b0 = cvtpk(P[BASE + 4], P[BASE + 5]), b1 = cvtpk(P[BASE + 6], P[BASE + 7]);                              \
    auto r0 = __builtin_amdgcn_permlane32_swap(a0, b0, false, false); auto r1 = __builtin_amdgcn_permlane32_swap(a1, b1, false, false); \
    u32x4 w = {r0[0], r1[0], r0[1], r1[1]}; OUT = *reinterpret_cast<bf16x8*>(&w); } while (0)
  PK4(p0, 0, pa0); PK4(p0, 8, pa1); PK4(p1, 0, pa2); PK4(p1, 8, pa3);
#undef PK4
}
template <int MODE>
__device__ __forceinline__ void qkt(f32x16& p0, f32x16& p1, const char* Ks, const bf16x8* qr, int r32, int hi) {
  p0 = f32x16{}; p1 = f32x16{};
  #pragma unroll
  for (int d0 = 0; d0 < ACfg<MODE>::ND0; ++d0) { int cb = (d0 * 16 + hi * 8) * 2;
    bf16x8 b0 = *reinterpret_cast<const bf16x8*>(Ks + KSWZ(r32, cb));
    bf16x8 b1 = *reinterpret_cast<const bf16x8*>(Ks + KSWZ(32 + r32, cb));
    p0 = __builtin_amdgcn_mfma_f32_32x32x16_bf16(b0, qr[d0], p0, 0, 0, 0);
    p1 = __builtin_amdgcn_mfma_f32_32x32x16_bf16(b1, qr[d0], p1, 0, 0, 0); }
}
__device__ __forceinline__ int v_st(int k, int c) { const int kk = (k & ~0xC) | ((k & 4) << 1) | ((k & 8) >> 1); return ((kk >> 3) * 4 + (c >> 5)) * 512 + ((kk & 7) * 32 + (c & 31)) * 2; }
__device__ __forceinline__ int v_rd_base(int lane) { return ((lane & 3) << 3) | (((lane >> 2) & 3) << 6) | (((lane >> 4) & 1) << 5) | (((lane >> 5) & 1) << 8); }
constexpr int v_rd_off(int d0, int ks, int half) { return d0 * 512 + ks * 4096 + half * 2048; }
template <int OFF> __device__ __forceinline__ s16x4 tr_read(int vb) {
  s16x4 r; asm volatile("ds_read_b64_tr_b16 %0, %1 offset:%2" : "=&v"(r) : "v"(vb), "i"(OFF) : "memory"); return r;
}
template <int D0> __device__ __forceinline__ void pv_one(f32x16& od, int vb, bf16x8 pa0, bf16x8 pa1, bf16x8 pa2, bf16x8 pa3) {
  const s16x4 l0 = tr_read<v_rd_off(D0, 0, 0)>(vb), h0 = tr_read<v_rd_off(D0, 0, 1)>(vb), l1 = tr_read<v_rd_off(D0, 1, 0)>(vb), h1 = tr_read<v_rd_off(D0, 1, 1)>(vb);
  const s16x4 l2 = tr_read<v_rd_off(D0, 2, 0)>(vb), h2 = tr_read<v_rd_off(D0, 2, 1)>(vb), l3 = tr_read<v_rd_off(D0, 3, 0)>(vb), h3 = tr_read<v_rd_off(D0, 3, 1)>(vb);
  asm volatile("s_waitcnt lgkmcnt(0)" ::: "memory"); SBAR();
#define PK(L, H) (bf16x8){L[0], L[1], L[2], L[3], H[0], H[1], H[2], H[3]}
  od = __builtin_amdgcn_mfma_f32_32x32x16_bf16(pa0, PK(l0, h0), od, 0, 0, 0);
  od = __builtin_amdgcn_mfma_f32_32x32x16_bf16(pa1, PK(l1, h1), od, 0, 0, 0);
  od = __builtin_amdgcn_mfma_f32_32x32x16_bf16(pa2, PK(l2, h2), od, 0, 0, 0);
  od = __builtin_amdgcn_mfma_f32_32x32x16_bf16(pa3, PK(l3, h3), od, 0, 0, 0);
#undef PK
}
template <int MODE>
__device__ __forceinline__ void pv_all(f32x16* o, int vb, bf16x8 pa0, bf16x8 pa1, bf16x8 pa2, bf16x8 pa3) {
  pv_one<0>(o[0], vb, pa0, pa1, pa2, pa3); pv_one<1>(o[1], vb, pa0, pa1, pa2, pa3);
  if constexpr (ACfg<MODE>::NDV == 4) { pv_one<2>(o[2], vb, pa0, pa1, pa2, pa3); pv_one<3>(o[3], vb, pa0, pa1, pa2, pa3); }
  else {
    const bf16x8 ones = {16256, 16256, 16256, 16256, 16256, 16256, 16256, 16256};
    o[2] = __builtin_amdgcn_mfma_f32_32x32x16_bf16(pa0, ones, o[2], 0, 0, 0);
    o[2] = __builtin_amdgcn_mfma_f32_32x32x16_bf16(pa1, ones, o[2], 0, 0, 0);
    o[2] = __builtin_amdgcn_mfma_f32_32x32x16_bf16(pa2, ones, o[2], 0, 0, 0);
    o[2] = __builtin_amdgcn_mfma_f32_32x32x16_bf16(pa3, ones, o[2], 0, 0, 0);
  }
}

template <int MODE>
__device__ __forceinline__ void attn_body(const bf16* __restrict__ Qb, const bf16* __restrict__ Kp, const bf16* __restrict__ Kr, const bf16* __restrict__ Vp,
                                          int lat_row, int ctx_row, int nt_lat, int NT, f32x16* o, float& l_out, char* lds) {
  constexpr int ND0 = ACfg<MODE>::ND0, NDV = ACfg<MODE>::NDV, NACC = MODE ? 3 : 4;
  constexpr int LDQ = MODE ? 1536 : 1024, LDK = MODE ? 2048 : 1024;
  const int tid = otid(), wid = tid >> 6, lane = tid & 63, r32 = lane & 31, hi = lane >> 5;
  char* V_lds = lds; char* K_lds = lds + 2 * SHM_V;
  float* wsl = (float*)(lds + 2 * SHM_V + 2 * SHM_K) + wid * 64; float* al_l = wsl + 32;
  float m_reg = -1e30f, l_reg = 0;
  #pragma unroll
  for (int d = 0; d < NACC; ++d) { float zz = 0.f; asm volatile("" : "+v"(zz));
    _Pragma("unroll") for (int r = 0; r < 16; ++r) o[d][r] = zz; }
  bf16x8 qr[ND0];
  const bf16* Qw = Qb + (size_t)(wid * 32 + r32) * LDQ + hi * 8;
  #pragma unroll
  for (int d0 = 0; d0 < ND0; ++d0) qr[d0] = *reinterpret_cast<const bf16x8*>(Qw + d0 * 16);
  const int vb0 = (int)(uintptr_t)V_lds + v_rd_base(lane);
  const int kkey = tid >> 3, kpc = tid & 7;
  const int sr = tid >> 4, sc = (tid & 15) * 8;
  const int rkey = (tid >> 2) & 63, rpc = tid & 3;
  const int ks_off = KSWZ(kkey, kpc * 16), kr_off = KSWZ(rkey, 128 + rpc * 16);
  const int vst0 = MODE ? v_st(kkey, kpc * 8) : v_st(sr, sc), vst1 = v_st(32 + sr, sc);
  bf16x8 sa0, sb0, sc0, sa1, sb1, sc1;
#define KROW(j) ((j) < nt_lat ? lat_row + (j) * 64 : ctx_row + ((j) - nt_lat) * 64)
#define SLOAD(A_, B_, C_, j) do { const int kr0 = KROW(j); \
    if constexpr (MODE == 0) { A_ = *reinterpret_cast<const bf16x8*>(Kp + (size_t)(kr0 + kkey) * LDK + kpc * 8); \
      B_ = *reinterpret_cast<const bf16x8*>(Vp + (size_t)(kr0 + sr) * LDK + sc); C_ = *reinterpret_cast<const bf16x8*>(Vp + (size_t)(kr0 + 32 + sr) * LDK + sc); } \
    else { A_ = *reinterpret_cast<const bf16x8*>(Kp + (size_t)(kr0 + kkey) * LDK + kpc * 8); \
      B_ = *reinterpret_cast<const bf16x8*>(Vp + (size_t)(kr0 + kkey) * LDK + kpc * 8); C_ = *reinterpret_cast<const bf16x8*>(Kr + (size_t)(kr0 + rkey) * 32 + rpc * 8); } } while (0)
#define SWRITE(b, A_, B_, C_) do { *reinterpret_cast<bf16x8*>(K_lds + (b) * SHM_K + ks_off) = A_; \
    if constexpr (MODE == 0) { *reinterpret_cast<bf16x8*>(V_lds + (b) * SHM_V + vst0) = B_; *reinterpret_cast<bf16x8*>(V_lds + (b) * SHM_V + vst1) = C_; } \
    else { *reinterpret_cast<bf16x8*>(V_lds + (b) * SHM_V + vst0) = B_; *reinterpret_cast<bf16x8*>(K_lds + (b) * SHM_K + kr_off) = C_; } } while (0)
#define SWAIT() asm volatile("s_waitcnt vmcnt(3)" ::: "memory")
#define RESC(a) do { if (__any((a) < 1.f)) { if (hi == 0) al_l[r32] = (a); asm volatile("s_waitcnt lgkmcnt(0)" ::: "memory"); \
    _Pragma("unroll") for (int d = 0; d < NACC; ++d) _Pragma("unroll") for (int r = 0; r < 16; ++r) o[d][r] *= al_l[crow(r, hi)]; } } while (0)
  f32x16 pA0, pA1, pB0, pB1; float mnA, mnB, alA, alB; bf16x8 pa0, pa1, pa2, pa3;
  SLOAD(sa0, sb0, sc0, 0); asm volatile("s_waitcnt vmcnt(0)" ::: "memory"); SWRITE(0, sa0, sb0, sc0); __syncthreads();
  qkt<MODE>(pA0, pA1, K_lds, qr, r32, hi); partialSM<MODE>(pA0, pA1, m_reg, mnA, alA);
  SLOAD(sa1, sb1, sc1, 1); if (2 < NT) SLOAD(sa0, sb0, sc0, 2);
  SWAIT(); SWRITE(1, sa1, sb1, sc1); __syncthreads();
  for (int j = 1; j + 1 < NT; j += 2) {
    SBAR(); qkt<MODE>(pB0, pB1, K_lds + SHM_K, qr, r32, hi);
    finishSM<MODE == 0>(pA0, pA1, alA, l_reg, pa0, pa1, pa2, pa3); SBAR();
    SLOAD(sa1, sb1, sc1, j + 2); SBAR();
    pv_all<MODE>(o, vb0, pa0, pa1, pa2, pa3); partialSM<MODE>(pB0, pB1, m_reg, mnB, alB);
    __syncthreads(); SWAIT(); SWRITE(0, sa0, sb0, sc0);
    RESC(alB); __syncthreads();
    SBAR(); qkt<MODE>(pA0, pA1, K_lds, qr, r32, hi);
    finishSM<MODE == 0>(pB0, pB1, alB, l_reg, pa0, pa1, pa2, pa3); SBAR();
    if (j + 3 < NT) SLOAD(sa0, sb0, sc0, j + 3); SBAR();
    pv_all<MODE>(o, vb0 + SHM_V, pa0, pa1, pa2, pa3); partialSM<MODE>(pA0, pA1, m_reg, mnA, alA);
    __syncthreads(); SWAIT(); SWRITE(1, sa1, sb1, sc1);
    RESC(alA); __syncthreads();
  }
  SBAR(); qkt<MODE>(pB0, pB1, K_lds + SHM_K, qr, r32, hi);
  finishSM<MODE == 0>(pA0, pA1, alA, l_reg, pa0, pa1, pa2, pa3); SBAR();
  pv_all<MODE>(o, vb0, pa0, pa1, pa2, pa3); partialSM<MODE>(pB0, pB1, m_reg, mnB, alB);
  __syncthreads(); RESC(alB);
  finishSM<MODE == 0>(pB0, pB1, alB, l_reg, pa0, pa1, pa2, pa3); SBAR();
  pv_all<MODE>(o, vb0 + SHM_V, pa0, pa1, pa2, pa3);
  l_out = l_reg;
  __syncthreads();
#undef KROW
#undef SLOAD
#undef SWRITE
#undef SWAIT
#undef RESC
}

__device__ __forceinline__ void diff_unit(unsigned char* ws, int qrow0, int h, int lat_row, int ctx_row, int nt_lat, int NT,
                                          float lam, float oscale, const float* subln, char* lds, bool dry = false) {
  const int tid = otid(), wid = tid >> 6, lane = tid & 63, r32 = lane & 31, hi = lane >> 5;
  bf16* qb = (bf16*)(ws + WS_QB); const bf16* kb = (const bf16*)(ws + WS_KB); const bf16* vb = (const bf16*)(ws + WS_VB);
  float* stash = (float*)(ws + WS_YTMP);
  float* li_l = (float*)(lds + 2 * SHM_V + 2 * SHM_K) + wid * 64;
  #pragma unroll 1
  for (int mp = 0; mp < 2; ++mp) {
    f32x16 o[4]; float l_reg;
    attn_body<0>(qb + (size_t)qrow0 * 1024 + h * 128 + mp * 64, kb + h * 128 + mp * 64, nullptr, vb + h * 128, lat_row, ctx_row, nt_lat, NT, o, l_reg, lds);
    if (hi == 0) li_l[r32] = l_reg;
    asm volatile("s_waitcnt lgkmcnt(0)" ::: "memory");
    __attribute__((address_space(1))) char* sq = (__attribute__((address_space(1))) char*)(stash + (size_t)(qrow0 + wid * 32 + hi * 4) * 1024 + h * 128 + r32);
    if (mp == 0) {
      #pragma unroll
      for (int r = 0; r < 16; ++r) { const float rl = __builtin_amdgcn_rcpf(li_l[crow(r, hi)]);
        asm volatile("" : "+v"(sq));
        #pragma unroll
        for (int d0 = 0; d0 < 4; ++d0) ((__attribute__((address_space(1))) float*)sq)[d0 * 32] = o[d0][r] * rl;
        sq += ((r & 3) == 3 ? 5 : 1) * 4096; }
    } else {
      __attribute__((address_space(1))) char* oq = (__attribute__((address_space(1))) char*)(qb + (size_t)(qrow0 + wid * 32 + hi * 4) * 1024 + h * 128 + r32);
      float g4[4];
      #pragma unroll
      for (int d0 = 0; d0 < 4; ++d0) g4[d0] = subln[d0 * 32 + r32] * oscale;
      #pragma unroll
      for (int r = 0; r < 16; ++r) { const float rl = __builtin_amdgcn_rcpf(li_l[crow(r, hi)]);
        asm volatile("" : "+v"(sq)); asm volatile("" : "+v"(oq));
        float d[4]; float ss = 0.f;
        #pragma unroll
        for (int d0 = 0; d0 < 4; ++d0) { d[d0] = ((const __attribute__((address_space(1))) float*)sq)[d0 * 32] - lam * (o[d0][r] * rl); ss += d[d0] * d[d0]; }
        ss = DPP_ADD(ss, 0xB1); ss = DPP_ADD(ss, 0x4E); ss = DPP_ADD(ss, 0x141); ss = DPP_ADD(ss, 0x140); ss += shx(ss, 16);
        const float rn = rsqrtf(ss * (1.f / 128.f) + EPS);
        if (!dry) { _Pragma("unroll") for (int d0 = 0; d0 < 4; ++d0) ((__attribute__((address_space(1))) u16*)oq)[d0 * 32] = f2bf(d[d0] * rn * g4[d0]); }
        sq += ((r & 3) == 3 ? 5 : 1) * 4096; oq += ((r & 3) == 3 ? 5 : 1) * 2048; }
    }
    __syncthreads();
  }
}
__device__ __forceinline__ void mla_unit(unsigned char* ws, int qrow0, int h, int lat_row, int ctx_row, int nt_lat, int NT, char* lds) {
  const int tid = otid(), wid = tid >> 6, lane = tid & 63, r32 = lane & 31, hi = lane >> 5;
  const bf16* qc = (const bf16*)(ws + WS_QC); const bf16* kvc = (const bf16*)(ws + WS_KVC); const bf16* kr = (const bf16*)(ws + WS_KR);
  bf16* oc = (bf16*)(ws + WS_OC);
  float* li_l = (float*)(lds + 2 * SHM_V + 2 * SHM_K) + wid * 64;
  f32x16 o[3]; float l_reg;
  attn_body<1>(qc + (size_t)qrow0 * 1536 + h * 96, kvc + h * 128, kr, kvc + h * 128 + 64, lat_row, ctx_row, nt_lat, NT, o, l_reg, lds);
  __attribute__((address_space(1))) char* oq = (__attribute__((address_space(1))) char*)(oc + (size_t)(qrow0 + wid * 32 + hi * 4) * 1024 + h * 64 + r32);
  #pragma unroll
  for (int r = 0; r < 16; ++r) { const float rl = __builtin_amdgcn_rcpf(o[2][r]);
    asm volatile("" : "+v"(oq));
    #pragma unroll
    for (int d0 = 0; d0 < 2; ++d0) ((__attribute__((address_space(1))) u16*)oq)[d0 * 32] = f2bf(o[d0][r] * rl);
    oq += ((r & 3) == 3 ? 5 : 1) * 2048; }
  __syncthreads();
}

__device__ __forceinline__ void sg_unit(unsigned char* ws, bf16* oa_base, int chunk, int g, const float* lng, const float* lnb, const float* spw, const float* spb, char* lds) {
  const int tid = otid(), wid = tid >> 6, lane = tid & 63, fr = lane & 15, fq = lane >> 4;
  bf16* ga = (bf16*)(ws + WS_GA) + (size_t)chunk * 128 * 2048;
  constexpr int LDT = 136;
  u16* wS = (u16*)lds;
  u16* vT = (u16*)(lds + 128 * LDT * 2);
  float* mu = (float*)(lds + 2 * 128 * LDT * 2); float* rs = mu + 128;
  #pragma unroll 1
  for (int i0 = 0; i0 < 16; i0 += 4) {
    bf16x8 a[4], b[4];
    #pragma unroll
    for (int q = 0; q < 4; ++q) { const bf16* vp = ga + (size_t)(wid * 16 + i0 + q) * 2048 + 1024 + lane * 16;
      a[q] = *reinterpret_cast<const bf16x8*>(vp); b[q] = *reinterpret_cast<const bf16x8*>(vp + 8); }
    #pragma unroll
    for (int q = 0; q < 4; ++q) {
      float x[16];
      #pragma unroll
      for (int k = 0; k < 8; ++k) { x[k] = bf2f((u16)a[q][k]); x[8 + k] = bf2f((u16)b[q][k]); }
      float s = 0.f;
      #pragma unroll
      for (int k = 0; k < 16; ++k) s += x[k];
      s = wave_sum(s);
      const float mean = s * (1.f / 1024.f);
      float qq = 0.f;
      #pragma unroll
      for (int k = 0; k < 16; ++k) { float d = x[k] - mean; qq += d * d; }
      qq = wave_sum(qq);
      if (lane == 0) { mu[wid * 16 + i0 + q] = mean; rs[wid * 16 + i0 + q] = rsqrtf(qq * (1.f / 1024.f) + EPS); }
    }
  }
  #pragma unroll
  for (int it = 0; it < 8; ++it) { const int idx = tid + it * NTHR;
    const int i = idx >> 5, j4 = (idx & 31) * 4;
    f32x4 w = *reinterpret_cast<const f32x4*>(spw + (size_t)g * 16384 + i * 128 + j4);
    u32x2 pk = {cvtpk(w[0], w[1]), cvtpk(w[2], w[3])};
    *reinterpret_cast<u32x2*>(wS + i * LDT + j4) = pk;
  }
  __syncthreads();
  #pragma unroll
  for (int it = 0; it < 4; ++it) { const int idx = tid + it * NTHR;
    const int j = idx & 127, c8 = (idx >> 7) * 8;
    bf16x8 v = *reinterpret_cast<const bf16x8*>(ga + (size_t)j * 2048 + 1024 + g * 128 + c8);
    const float m_ = mu[j], r_ = rs[j];
    #pragma unroll
    for (int k = 0; k < 8; ++k) { const int c = c8 + k;
      float y = (bf2f((u16)v[k]) - m_) * r_ * lng[g * 128 + c] + lnb[g * 128 + c];
      vT[c * LDT + j] = f2bf(y); }
  }
  __syncthreads();
  bf16x8 af[4];
  #pragma unroll
  for (int k = 0; k < 4; ++k) af[k] = *reinterpret_cast<const bf16x8*>(wS + (wid * 16 + fr) * LDT + k * 32 + fq * 8);
  u16 uv[8][4];
  #pragma unroll
  for (int cb = 0; cb < 8; ++cb)
  #pragma unroll
  for (int j = 0; j < 4; ++j) uv[cb][j] = *reinterpret_cast<const u16*>(ga + (size_t)(wid * 16 + fq * 4 + j) * 2048 + g * 128 + cb * 16 + fr);
  #pragma unroll
  for (int cb = 0; cb < 8; ++cb) {
    f32x4 acc = {0.f, 0.f, 0.f, 0.f};
    #pragma unroll
    for (int k = 0; k < 4; ++k) {
      bf16x8 bfr = *reinterpret_cast<const bf16x8*>(vT + (cb * 16 + fr) * LDT + k * 32 + fq * 8);
      acc = __builtin_amdgcn_mfma_f32_16x16x32_bf16(af[k], bfr, acc, 0, 0, 0);
    }
    #pragma unroll
    for (int j = 0; j < 4; ++j) {
      const int i = wid * 16 + fq * 4 + j;
      const float z = acc[j] + spb[g * 128 + i];
      *reinterpret_cast<u16*>(oa_base + ((size_t)chunk * 128 + i) * 1024 + g * 128 + cb * 16 + fr) = f2bf(bf2f(uv[cb][j]) * z);
    }
  }
  __syncthreads();
}

__device__ __forceinline__ int perm_col(int ptype, int n) {
  if (ptype == 1) { int t = n / DFF, c = n - t * DFF; return 256 * (c >> 7) + 128 * t + (c & 127); }
  if (ptype == 2 && n >= 2048 && n < 4096) { int d = n & 63; int s = d >> 5, c = (d >> 4) & 1, i = d & 15; return (n & ~63) + c * 32 + s * 16 + i; }
  return n;
}
__device__ __forceinline__ void tconv_tile(const float* __restrict__ src, int N, int k0, int n0, bf16* __restrict__ dst, int K, int ptype, const float* kscale, float* tl) {
  const int tid = otid();
  #pragma unroll
  for (int i = 0; i < 2; ++i) {
    const int idx = tid + i * NTHR, kk = idx >> 4, c4 = (idx & 15) * 4;
    float zz = 0.f; asm volatile("" : "+v"(zz));
    f32x4 v = {zz, zz, zz, zz};
    if (n0 + c4 < N) v = *reinterpret_cast<const f32x4*>(src + (size_t)(k0 + kk) * N + n0 + c4);
    if (kscale) { const float s = kscale[k0 + kk]; v[0] *= s; v[1] *= s; v[2] *= s; v[3] *= s; }
    tl[kk * 65 + c4 + 0] = v[0]; tl[kk * 65 + c4 + 1] = v[1]; tl[kk * 65 + c4 + 2] = v[2]; tl[kk * 65 + c4 + 3] = v[3];
  }
  __syncthreads();
  { const int nn = tid >> 3, kg = (tid & 7) * 8;
    if (n0 + nn < N) {
      u32x4 w;
      w[0] = cvtpk(tl[(kg + 0) * 65 + nn], tl[(kg + 1) * 65 + nn]); w[1] = cvtpk(tl[(kg + 2) * 65 + nn], tl[(kg + 3) * 65 + nn]);
      w[2] = cvtpk(tl[(kg + 4) * 65 + nn], tl[(kg + 5) * 65 + nn]); w[3] = cvtpk(tl[(kg + 6) * 65 + nn], tl[(kg + 7) * 65 + nn]);
      *reinterpret_cast<u32x4*>(dst + (size_t)perm_col(ptype, n0 + nn) * K + k0 + kg) = w;
    } }
  __syncthreads();
}
struct ConvJob { const float* src; bf16* dst; const float* kscale; int K, N, ptype; };
__device__ __forceinline__ ConvJob conv_job(const Params& p, int l, int j) {
  ConvJob c; c.kscale = nullptr; c.ptype = 0;
  unsigned char* wl = p.ws + WS_W + (size_t)l * W_LAYER;
  switch (j) {
    case 0: c.src = p.in[I_F1W13] + (size_t)l * 1024 * 5632; c.dst = (bf16*)(wl + WO_W13A); c.K = 1024; c.N = 5632; c.ptype = 1; break;
    case 1: c.src = p.in[I_F1W2] + (size_t)l * 2816 * 1024; c.dst = (bf16*)(wl + WO_W2A); c.K = 2816; c.N = 1024; break;
    case 2: c.src = p.in[I_F2W13] + (size_t)l * 1024 * 5632; c.dst = (bf16*)(wl + WO_W13B); c.K = 1024; c.N = 5632; c.ptype = 1; break;
    case 3: c.src = p.in[I_F2W2] + (size_t)l * 2816 * 1024; c.dst = (bf16*)(wl + WO_W2B); c.K = 2816; c.N = 1024; break;
    case 4: c.src = p.in[I_WIN] + (size_t)l * 1024 * NWIN; c.dst = (bf16*)(wl + WO_WIN); c.K = 1024; c.N = NWIN; c.ptype = 2; break;
    case 5: c.src = p.in[I_WUQ] + (size_t)l * 512 * 1536; c.dst = (bf16*)(wl + WO_WUQ); c.K = 512; c.N = 1536; c.kscale = p.in[I_QNG] + l * 512; break;
    case 6: c.src = p.in[I_WUKV] + (size_t)l * 256 * 2048; c.dst = (bf16*)(wl + WO_WUKV); c.K = 256; c.N = 2048; c.kscale = p.in[I_KVNG] + l * 256; break;
    case 7: case 8: case 9: c.src = p.in[I_WBR] + ((size_t)l * 3 + (j - 7)) * 1024 * 1024; c.dst = (bf16*)(wl + WO_WBR) + (size_t)(j - 7) * 1024 * 1024; c.K = 1024; c.N = 1024; break;
    default: c.src = p.in[I_WOUT] + (size_t)l * 1024 * 1024; c.dst = (bf16*)(wl + WO_WOUT); c.K = 1024; c.N = 1024; break;
  }
  return c;
}

__device__ __forceinline__ void conv_layer(const Params& p, int l, int part, int nparts, int worker, int nworkers, char* lds, int j0 = 0, int j1 = 11) {
  float* tl = (float*)lds; int base = 0;
  const int s = nparts * nworkers, r = part + nparts * worker;
  for (int j = j0; j < j1; ++j) {
    ConvJob c = conv_job(p, l, j);
    const int nk = c.K / 64, nn = (c.N + 63) / 64, ntile = nk * nn;
    for (int t = (((r - base) % s) + s) % s; t < ntile; t += s) { const int tn = t / nk, tk = t - tn * nk; tconv_tile(c.src, c.N, tk * 64, tn * 64, c.dst, c.K, c.ptype, c.kscale, tl); }
    base += ntile;
  }
}
__device__ __forceinline__ void phase_prep(const Params& p, char* lds) {
  const int tid = otid(), G = ogx(), bx = obx();
  const long gtid = (long)bx * NTHR + tid, gsz = (long)G * NTHR;
  { float* cosb = (float*)(p.ws + WS_COSB); float* sinb = (float*)(p.ws + WS_SINB);
    for (long i = gtid; i < 4096 * 32; i += gsz) { int t = (int)(i >> 5), f = (int)(i & 31);
      float fr = powf(10000.f, -(float)(f & 15) / 16.f); float ang = (float)(f < 16 ? (t >> 6) : (t & 63)) * fr;
      cosb[i] = cosf(ang); sinb[i] = sinf(ang); }
    float* cosc = (float*)(p.ws + WS_COSC); float* sinc = (float*)(p.ws + WS_SINC);
    for (long i = gtid; i < 4096 * 16; i += gsz) { int t = (int)(i >> 4), f = (int)(i & 15);
      float fr = powf(10000.f, -(float)(f & 7) / 8.f); float ang = (float)(f < 8 ? (t >> 6) : (t & 63)) * fr;
      cosc[i] = cosf(ang); sinc[i] = sinf(ang); } }
  if (bx == 0 && tid < 128) {
    const int l = tid >> 6, k = tid & 63;
    float a = p.in[I_LQ1][l * 64 + k] * p.in[I_LK1][l * 64 + k], b = p.in[I_LQ2][l * 64 + k] * p.in[I_LK2][l * 64 + k];
    #pragma unroll
    for (int o = 1; o < 64; o <<= 1) { a += shx(a, o); b += shx(b, o); }
    if (k == 0) { const float lam_init = 0.8f - 0.6f * expf(-0.3f * (float)l); ((float*)(p.ws + WS_LAM))[l] = expf(a) - expf(b) + lam_init; }
  }
  for (int l = 0; l < 2; ++l) { u32x4* z = (u32x4*)(p.ws + WS_W + (size_t)l * W_LAYER + WO_WIN + (size_t)NWIN * 1024 * 2);
    unsigned z0 = 0; asm volatile("" : "+v"(z0));
    for (long i = gtid; i < (long)(NWINP - NWIN) * 1024 * 2 / 16; i += gsz) z[i] = u32x4{z0, z0, z0, z0}; }
  { float* sl = (float*)lds;
    float* red = sl + 9 * 1024;
    float* mod = (float*)(p.ws + WS_MOD);
    if (bx < 2 * 144) {
      for (int i = tid; i < 9 * 1024; i += NTHR) sl[i] = siluf_(i < 8192 ? p.in[I_C][i] : p.in[I_CCTX][i - 8192]);
      __syncthreads();
    }
    const int col = tid & 63, kg = tid >> 6;
    for (int it = bx; it < 2 * 144; it += G) {
      const int l = it / 144, n0 = (it % 144) * 64;
      const float* W = p.in[I_ADAW] + (size_t)l * 1024 * 9216 + n0 + col;
      float acc[9];
      #pragma unroll
      for (int j = 0; j < 9; ++j) acc[j] = 0.f;
      for (int k = kg * 128; k < kg * 128 + 128; ++k) {
        const float w = W[(size_t)k * 9216];
        #pragma unroll
        for (int j = 0; j < 9; ++j) acc[j] += sl[j * 1024 + k] * w;
      }
      #pragma unroll
      for (int j = 0; j < 9; ++j) red[(kg * 9 + j) * 64 + col] = acc[j];
      __syncthreads();
      for (int o = tid; o < 9 * 64; o += NTHR) { const int j = o >> 6, c = o & 63; float sm = 0.f;
        #pragma unroll
        for (int q = 0; q < 8; ++q) sm += red[(q * 9 + j) * 64 + c];
        mod[((size_t)l * 9 + j) * 9216 + n0 + c] = sm + p.in[I_ADAB][l * 9216 + n0 + c]; }
      __syncthreads();
    } }
  if (G == 256) conv_layer(p, 0, 0, 1, bx, G, lds, 0, 2);
  else { conv_layer(p, 0, 0, 1, bx, G, lds); conv_layer(p, 1, 0, 1, bx, G, lds); }
}

__device__ __forceinline__ void phase_norm(const Params& p, int l, int which) {
  const int tid_ = otid(); const int wid = tid_ >> 6, lane = tid_ & 63;
  const float* gain = p.in[which == 0 ? I_NFFN1 : (which == 1 ? I_NMIX : I_NFFN2)] + l * 1024;
  const float* mod = (const float*)(p.ws + WS_MOD) + (size_t)l * 9 * 9216;
  bf16* h = (bf16*)(p.ws + WS_H);
  for (int r0 = (obx() * 8 + wid) * 2; r0 < R_ALL; r0 += ogx() * 16) {
    const int rb = r0 & ~127;
    TileInfo ti = (l == 0 && which == 0) ? tile_info(rb, const_cast<float*>(p.in[I_X]), const_cast<float*>(p.in[I_CTX])) : tile_info(rb, p.out, (float*)(p.ws + WS_CTXRES));
    const float* x = ti.resid + (size_t)(r0 - rb) * DM;
    const float* sh = mod + (size_t)ti.mi * 9216 + (which * 3) * 1024; const float* sc = sh + 1024;
    f32x4 v[2][4]; float ss[2] = {0.f, 0.f};
    #pragma unroll
    for (int q = 0; q < 2; ++q)
    #pragma unroll
    for (int i = 0; i < 4; ++i) v[q][i] = *(const __attribute__((address_space(1))) f32x4*)(x + q * DM + i * 256 + lane * 4);
    #pragma unroll
    for (int q = 0; q < 2; ++q)
    #pragma unroll
    for (int i = 0; i < 4; ++i) ss[q] += v[q][i][0] * v[q][i][0] + v[q][i][1] * v[q][i][1] + v[q][i][2] * v[q][i][2] + v[q][i][3] * v[q][i][3];
    ss[0] = wave_sum(ss[0]); ss[1] = wave_sum(ss[1]);
    #pragma unroll
    for (int i = 0; i < 4; ++i) { const int c = i * 256 + lane * 4;
      f32x4 g = *reinterpret_cast<const f32x4*>(gain + c), s1 = *reinterpret_cast<const f32x4*>(sc + c), s0 = *reinterpret_cast<const f32x4*>(sh + c);
      #pragma unroll
      for (int q = 0; q < 2; ++q) { const float rn = rsqrtf(ss[q] * (1.f / 1024.f) + EPS); f32x4 y;
        #pragma unroll
        for (int j = 0; j < 4; ++j) y[j] = v[q][i][j] * rn * g[j] * (1.f + s1[j]) + s0[j];
        st4bf(h + (size_t)(r0 + q) * 1024 + c, y); } }
  }
}
__device__ __forceinline__ void phase_final(const Params& p) {
  const int tid_ = otid(); const int wid = tid_ >> 6, lane = tid_ & 63;
  const float* gain = p.in[I_NFINAL];
  for (int r = obx() * 8 + wid; r < NB * SEQ; r += ogx() * 8) {
    float* x = p.out + (size_t)r * DM;
    f32x4 v[4]; float ss = 0.f;
    #pragma unroll
    for (int i = 0; i < 4; ++i) { v[i] = *reinterpret_cast<const f32x4*>(x + i * 256 + lane * 4);
      ss += v[i][0] * v[i][0] + v[i][1] * v[i][1] + v[i][2] * v[i][2] + v[i][3] * v[i][3]; }
    ss = wave_sum(ss);
    const float rn = rsqrtf(ss * (1.f / 1024.f) + EPS);
    #pragma unroll
    for (int i = 0; i < 4; ++i) { const int c = i * 256 + lane * 4;
      f32x4 g = *reinterpret_cast<const f32x4*>(gain + c), y;
      #pragma unroll
      for (int j = 0; j < 4; ++j) y[j] = v[i][j] * rn * g[j];
      *reinterpret_cast<f32x4*>(x + c) = y; }
  }
}

__device__ __forceinline__ void phase_ffn_up(const Params& p, int l, int which, char* lds) {
  GridSched S{(const char*)(p.ws + WS_H), (const char*)(p.ws + WS_W + (size_t)l * W_LAYER + (which ? WO_W13B : WO_W13A)), (l == 1 && which == 1) ? 128 : R_ALL / 256, 5632 / 256, ogx(), obx(), (size_t)256 * 1024 * 2, 1, (l == 1 && which == 1)};
  EpiSwiglu E{(bf16*)(p.ws + WS_ACT)};
  gemm_phase((LAS unsigned char*)lds, 1024, S, E);
}
__device__ __forceinline__ void phase_ffn_down(const Params& p, int l, int which, char* lds) {
  GridSched S{(const char*)(p.ws + WS_ACT), (const char*)(p.ws + WS_W + (size_t)l * W_LAYER + (which ? WO_W2B : WO_W2A)), (l == 1 && which == 1) ? 128 : R_ALL / 256, 4, ogx(), obx(), (size_t)256 * DFF * 2, 1, (l == 1 && which == 1)};
  EpiResid E{p.out, (float*)(p.ws + WS_CTXRES), (const float*)(p.ws + WS_MOD) + (size_t)l * 9 * 9216 + (which ? 8 : 2) * 1024, 0.5f, 0, 0, (l == 0 && which == 0) ? p.in[I_X] : p.out, (l == 0 && which == 0) ? p.in[I_CTX] : (const float*)(p.ws + WS_CTXRES)};
#ifdef REP_RESID
  { EpiResid E2 = E; E2.dry = 1; gemm_phase((LAS unsigned char*)lds, DFF, S, E2); }
#endif
  gemm_phase((LAS unsigned char*)lds, DFF, S, E);
  { const int G = ogx(), bx = obx(); if (l == 0 && which == 0 && G == 256 && bx >= 32) conv_layer(p, 0, 0, 1, bx - 32, G - 32, lds, 2, 11); }
}
__device__ __forceinline__ void phase_win(const Params& p, int l, int g, char* lds) {
  GridSched S{(const char*)(p.ws + WS_H + (size_t)g * GR * 1024 * 2), (const char*)(p.ws + WS_W + (size_t)l * W_LAYER + WO_WIN), GR / 256, NWINP / 256, ogx(), obx(), (size_t)256 * 1024 * 2, 1, 0};
  EpiWin E{p.ws, p.in[I_BGATE] + l * 3072, g * GR};
  gemm_phase((LAS unsigned char*)lds, 1024, S, E);
}
__device__ __forceinline__ void phase_up(const Params& p, int l, int g, char* lds) {
  const int G = ogx(), bx = obx();
  { GridSched S{(const char*)(p.ws + WS_CQ), (const char*)(p.ws + WS_W + (size_t)l * W_LAYER + WO_WUQ), GR / 256, 6, G, bx, (size_t)256 * 512 * 2, 0, 0};
    EpiUp<1> E{p.ws, g * GR}; gemm_phase((LAS unsigned char*)lds, 512, S, E); }
  { GridSched S{(const char*)(p.ws + WS_CKV), (const char*)(p.ws + WS_W + (size_t)l * W_LAYER + WO_WUKV), GR / 256, 8, G, (bx + G - (204 % G)) % G, (size_t)256 * 256 * 2, 0, 0};
    EpiUp<0> E{p.ws, g * GR}; gemm_phase((LAS unsigned char*)lds, 256, S, E); }
}
__device__ __forceinline__ void phase_merge(const Params& p, int l, int g, char* lds) {
  MergeSched S{(const char*)(p.ws + WS_H + (size_t)g * GR * 1024 * 2), (const char*)(p.ws + WS_QB), (const char*)(p.ws + WS_OC),
               (const char*)(p.ws + WS_W + (size_t)l * W_LAYER + WO_WBR), GR / 256, 4, ogx(), obx()};
  EpiMerge E{p.ws};
  gemm_phase<EpiMerge, MergeSched, true>((LAS unsigned char*)lds, 1024, S, E);
  { const int G = ogx(), bx = obx(); if (l == 0 && G == 256 && bx >= 136) conv_layer(p, 1, g, 4, bx - 136, G - 136, lds); }
}
__device__ __forceinline__ void phase_wout(const Params& p, int l, int g, char* lds) {
  const int G = ogx();
  GridSched S{(const char*)(p.ws + WS_Y), (const char*)(p.ws + WS_W + (size_t)l * W_LAYER + WO_WOUT), GR / 256, 4, G, (obx() + G - (120 % G)) % G, (size_t)256 * 1024 * 2, 2, 0};
  EpiResid E{p.out, (float*)(p.ws + WS_CTXRES), (const float*)(p.ws + WS_MOD) + (size_t)l * 9 * 9216 + 5 * 1024, 1.0f, g * GR, 0, p.out, (const float*)(p.ws + WS_CTXRES)};
#ifdef REP_RESID
  { EpiResid E2 = E; E2.dry = 1; gemm_phase((LAS unsigned char*)lds, 1024, S, E2); }
#endif
  gemm_phase((LAS unsigned char*)lds, 1024, S, E);
}

__device__ __forceinline__ void phase_mix(const Params& p, int l, int g, char* lds) {
  const float lam = ((const float*)(p.ws + WS_LAM))[l];
  const float lam_init = 0.8f - 0.6f * expf(-0.3f * (float)l);
  const float* subln = p.in[I_SUBLN] + l * 128;
  const int nctx = (l == 0) ? 48 : 0;
  const int nchunk = (l == 0 ? 68 : 64);
  const int nsg = ((nchunk + 7) / 8) * 64;
  const int total = 256 + 512 + nctx + nsg;
  for (int it = obx(); it < total; it += ogx()) {
#ifndef MIXM
#define MIXM 7
#endif
    if (it < 256) { if (!(MIXM & 1)) continue; const int pr = (it & 7) * 2 + (it >> 7), qb = (it >> 3) & 15; const int bb = pr >> 3, h = pr & 7;
#ifdef REP_DIFF
      diff_unit(p.ws, bb * 4096 + qb * 256, h, bb * 4096, GLAT + bb * 256, 64, 68, lam, 1.f - lam_init, subln, lds, true);
#endif
      diff_unit(p.ws, bb * 4096 + qb * 256, h, bb * 4096, GLAT + bb * 256, 64, 68, lam, 1.f - lam_init, subln, lds);
    } else if (it < 768) { if (!(MIXM & 2)) continue; const int i2 = it - 256; const int pr = (i2 >> 8) * 16 + (i2 & 7) * 2 + ((i2 >> 7) & 1), qb = (i2 >> 3) & 15; const int bb = pr >> 4, h = pr & 15;
      for (int rep = 0; rep < REP_MLA; ++rep) mla_unit(p.ws, bb * 4096 + qb * 256, h, bb * 4096, GLAT + bb * 256, 64, 68, lds);
    } else if (it < 768 + nctx) { const int i3 = it - 768;
      if (i3 < 16) { if (!(MIXM & 1)) continue; const int bb = i3 >> 3, h = i3 & 7; diff_unit(p.ws, GLAT + bb * 256, h, 0, GLAT + bb * 256, 0, 4, lam, 1.f - lam_init, subln, lds); }
      else { if (!(MIXM & 2)) continue; const int i4 = i3 - 16; const int bb = i4 >> 4, h = i4 & 15; mla_unit(p.ws, GLAT + bb * 256, h, 0, GLAT + bb * 256, 0, 4, lds); }
    } else { if (!(MIXM & 4)) continue; const int ch = it - 768 - nctx;
      const int sx = ch & 7, sk = ch >> 3, schunk = (sk >> 3) * 8 + sx; if (schunk >= nchunk) continue;
      sg_unit(p.ws, (bf16*)(p.ws + WS_H) + (size_t)g * GR * 1024, schunk, sk & 7, p.in[I_LNVG] + l * 1024, p.in[I_LNVB] + l * 1024, p.in[I_SPW] + (size_t)l * 8 * 16384, p.in[I_SPB] + l * 1024, lds);
    }
  }
}

#define XB_TMO      128
#define XB_XCNT(j)  (256  + 64 * (j))
#define XB_XSUB(j)  (1280 + 64 * (j))
#define XB_XGEN(j)  (2304 + 64 * (j))
#define XB_TOP      3328
#define XB_TOPGEN   3392
#define XCD_BAR_WORDS 3456
#define XB_SPIN_CAP (1u << 20)
__device__ __forceinline__ unsigned xb_ld(unsigned* p)              { return __hip_atomic_load(p, __ATOMIC_RELAXED, __HIP_MEMORY_SCOPE_AGENT); }
__device__ __forceinline__ unsigned xb_add(unsigned* p, unsigned v) { return __hip_atomic_fetch_add(p, v, __ATOMIC_RELAXED, __HIP_MEMORY_SCOPE_AGENT); }
__device__ __forceinline__ unsigned xb_xcc_id() { return (unsigned)__builtin_amdgcn_s_getreg((3 << 11) | 20) & 0xFu; }
#define XB_SPIN(cond, bar) do { unsigned _sp = 0; while (cond) { __builtin_amdgcn_s_sleep(1); \
    if ((++_sp & 255u) == 0u) { if (xb_ld(&(bar)[XB_TMO])) break; if (_sp > XB_SPIN_CAP) { atomicAdd(&(bar)[XB_TMO], 1u); break; } } } } while (0)
__device__ __forceinline__ void xcd_barrier_complete(unsigned* bar, unsigned x, unsigned& nloc, unsigned& nx) {
  const unsigned G = gridDim.x * gridDim.y * gridDim.z;
  unsigned sum, cnt, mine, sp = 0u;
  for (;;) {
    sum = 0u; cnt = 0u; mine = 0u;
    #pragma unroll
    for (unsigned j = 0; j < 16; ++j) { const unsigned c = xb_ld(&bar[XB_XCNT(j)]); sum += c; cnt += (c > 0u) ? 1u : 0u; mine = (j == x) ? c : mine; }
    if (sum == G) break;
    __builtin_amdgcn_s_sleep(1);
    if ((++sp & 255u) == 0u) { if (xb_ld(&bar[XB_TMO])) break; if (sp > XB_SPIN_CAP) { atomicAdd(&bar[XB_TMO], 1u); break; } }
  }
  nloc = mine > 0u ? mine : 1u; nx = cnt > 0u ? cnt : 1u;
}
__device__ __forceinline__ void xcd_barrier(unsigned* bar, volatile LAS unsigned* st) {
  asm volatile("s_waitcnt vmcnt(0) lgkmcnt(0)" ::: "memory");
  __syncthreads();
  if (threadIdx.x == 0) {
    const unsigned x = xb_xcc_id();
    unsigned nloc = st[0], nx = st[1];
    if (nloc == 0u) { xcd_barrier_complete(bar, x, nloc, nx); st[0] = nloc; st[1] = nx; }
    const unsigned old = xb_add(&bar[XB_XSUB(x)], 1u);
    const unsigned gen = old / nloc;
    if (old + 1u == (gen + 1u) * nloc) {
      __builtin_amdgcn_fence(__ATOMIC_RELEASE, "agent");
      asm volatile("s_waitcnt vmcnt(0)" ::: "memory");
      const unsigned og = xb_add(&bar[XB_TOP], 1u);
      const unsigned tg = og / nx;
      if (og + 1u == (tg + 1u) * nx) xb_add(&bar[XB_TOPGEN], 1u);
      else XB_SPIN(xb_ld(&bar[XB_TOPGEN]) == tg, bar);
      __builtin_amdgcn_fence(__ATOMIC_ACQUIRE, "agent");
      xb_add(&bar[XB_XGEN(x)], 1u);
      asm volatile("s_waitcnt vmcnt(0)" ::: "memory");
    } else {
      XB_SPIN(xb_ld(&bar[XB_XGEN(x)]) == gen, bar);
      __builtin_amdgcn_fence(__ATOMIC_ACQUIRE, "agent");
      asm volatile("s_waitcnt vmcnt(0)" ::: "memory");
    }
  }
  __syncthreads();
}

constexpr int N_PHASES = 50;
__device__ __forceinline__ void run_phase(const Params& p, int ph, char* lds) {
  if (ph == 0) { phase_prep(p, lds);
#ifdef REP_PREP
    phase_prep(p, lds);
#endif
    return; }
  if (ph == N_PHASES - 1) { phase_final(p); return; }
  const int l = (ph - 1) / 24, q = (ph - 1) % 24;
  if (q == 0) phase_norm(p, l, 0);
  else if (q == 1) { for (int rep = 0; rep < REP_GEMM; ++rep) phase_ffn_up(p, l, 0, lds); }
  else if (q == 2) phase_ffn_down(p, l, 0, lds);
  else if (q == 3) phase_norm(p, l, 1);
  else if (q < 21) { const int g = (q - 4) >> 2, s = (q - 4) & 3;
    if (s == 0) { if (g > 0) phase_wout(p, l, g - 1, lds);
      if (g < 4) { for (int rep = 0; rep < REP_GEMM; ++rep) phase_win(p, l, g, lds); } }
    else if (s == 1) { for (int rep = 0; rep < REP_GEMM; ++rep) phase_up(p, l, g, lds); }
    else if (s == 2) phase_mix(p, l, g, lds);
    else { for (int rep = 0; rep < REP_GEMM; ++rep) phase_merge(p, l, g, lds); }
  }
  else if (q == 21) phase_norm(p, l, 2);
  else if (q == 22) { for (int rep = 0; rep < REP_GEMM; ++rep) phase_ffn_up(p, l, 1, lds); }
  else phase_ffn_down(p, l, 1, lds);
}

__global__ void __launch_bounds__(NTHR, 2) mega(Params p) {
  extern __shared__ __attribute__((aligned(16))) char lds[];
#if MK_COOP
  cg::grid_group grid = cg::this_grid();
#endif
#if MK_COOP
  volatile LAS unsigned* xst = (volatile LAS unsigned*)((LAS unsigned char*)lds + LDS_SPARE);
  unsigned* xbar = (unsigned*)(p.ws + WS_XBAR);
  if (blockIdx.x == 0) for (int i = threadIdx.x; i < XCD_BAR_WORDS; i += NTHR) __hip_atomic_store(xbar + i, 0u, __ATOMIC_RELAXED, __HIP_MEMORY_SCOPE_AGENT);
  if (threadIdx.x < 2) xst[threadIdx.x] = 0u;
  grid.sync();
  if (threadIdx.x == 0) (void)xb_add(&xbar[XB_XCNT(xb_xcc_id())], 1u);
#endif
  for (int ph = p.ph_lo; ph < p.ph_hi; ++ph) {
    Params q = p;
    { __attribute__((address_space(1))) unsigned char* gws = (__attribute__((address_space(1))) unsigned char*)q.ws;
      __attribute__((address_space(1))) float* gout = (__attribute__((address_space(1))) float*)q.out;
      asm volatile("" : "+s"(gws), "+s"(gout));
      q.ws = (unsigned char*)gws; q.out = (float*)gout; }
    run_phase(q, ph, lds);
#if MK_COOP
    if (ph + 1 < p.ph_hi) xcd_barrier((unsigned*)(p.ws + WS_XBAR), (volatile LAS unsigned*)((LAS unsigned char*)lds + LDS_SPARE));
#endif
  }
}

extern "C" void kernel_launch(void* const* d_in, const int* in_sizes, int n_in, void* d_out, int out_size, void* d_ws, size_t ws_size, hipStream_t stream) {
  static int grid_blocks = 0;
  if (!grid_blocks) {
    int dev = 0, cus = 0, per_cu = 0;
    (void)hipGetDevice(&dev);
    (void)hipDeviceGetAttribute(&cus, hipDeviceAttributeMultiprocessorCount, dev);
    (void)hipFuncSetAttribute((const void*)mega, hipFuncAttributeMaxDynamicSharedMemorySize, LDS_BYTES);
    (void)hipOccupancyMaxActiveBlocksPerMultiprocessor(&per_cu, (const void*)mega, NTHR, LDS_BYTES);
    if (per_cu < 1) per_cu = 1;
    grid_blocks = cus * per_cu;
    if (ws_size < WS_END) fprintf(stderr, "kernel_launch: workspace too small: %zu < %zu\n", ws_size, (size_t)WS_END);
  }
  if (n_in < 31 || ws_size < WS_END) return;
  Params p{};
  for (int i = 0; i < 31; ++i) p.in[i] = (const float*)d_in[i];
  p.out = (float*)d_out; p.ws = (unsigned char*)d_ws;
#if MK_COOP
  (void)hipMemsetAsync((unsigned char*)d_ws + WS_BAR, 0, 256 + 16384, stream);
  p.ph_lo = 0; p.ph_hi = N_PHASES;
  void* args[] = {&p};
  hipError_t e = hipLaunchCooperativeKernel((void*)mega, dim3(grid_blocks), dim3(NTHR), args, LDS_BYTES, stream);
  if (e != hipSuccess) fprintf(stderr, "cooperative launch failed: %s (grid %d)\n", hipGetErrorString(e), grid_blocks);
#else
  for (int ph = 0; ph < N_PHASES; ++ph) { p.ph_lo = ph; p.ph_hi = ph + 1;
    hipLaunchKernelGGL(mega, dim3(grid_blocks), dim3(NTHR), LDS_BYTES, stream, p); }
#endif
}
```
